# Optimizing an MI355X kernel written in HIP

```python
import math
import jax, jax.numpy as jnp
from jax import lax
import numpy as np

D_MODEL = 1024
BATCH = 2
SEQ = 8192
DEPTH = 4

GRID_W = 64
CTX_LEN = 256
HEAD_DIM = 64
ATTN_HEADS = 8
ATTN_KV_HEADS = 2
GQA_GROUP = ATTN_HEADS // ATTN_KV_HEADS
ATTN_WIDTH = ATTN_HEADS * HEAD_DIM
KV_WIDTH = ATTN_KV_HEADS * HEAD_DIM
HYENA_WIDTH = D_MODEL // 4
NA_HEADS = 4
NA_WIDTH = NA_HEADS * HEAD_DIM
MIX_WIDTH = ATTN_WIDTH + HYENA_WIDTH + NA_WIDTH
IN_WIDTH = ATTN_WIDTH + 2 * KV_WIDTH + 3 * HYENA_WIDTH + 3 * NA_WIDTH
FFN_HIDDEN = 2816
Q_BLOCK = 128
NA_ROWS = 8
NA_COLS = 16
SHORT_CONV = 3
FILTER_BANDS = 16
FILTER_EMB = 2 * FILTER_BANDS + 1
FILTER_HIDDEN = 64
DECAY_TARGET = 1e-2
FAST_DECAY_PCT = 0.3
SLOW_DECAY_PCT = 1.5
ROPE_THETA = 10000.0
EPS = 1e-6
N_MOD = 9

kernel_name = 'hybrid_attn_hyena_natten_dit'


def rms_norm(x, g):
    xf = x.astype(jnp.float32)
    y = xf * lax.rsqrt(jnp.mean(xf * xf, axis=-1, keepdims=True) + EPS)
    return (y * g.astype(jnp.float32)).astype(x.dtype)


def modulate(n, shift, scale):
    return n * (1 + scale) + shift


def adaln_params(cond, w, b):
    m = jax.nn.silu(cond) @ w + b
    return jnp.split(m, N_MOD, axis=-1)


def swiglu(x, wg, wu, wd):
    return (jax.nn.silu(x @ wg) * (x @ wu)) @ wd


def to_heads(t, n_heads):
    b, n, _ = t.shape
    return t.reshape(b, n, n_heads, HEAD_DIM).transpose(0, 2, 1, 3)


def from_heads(t):
    b, h, n, dh = t.shape
    return t.transpose(0, 2, 1, 3).reshape(b, n, h * dh)


def split_proj(p):
    sizes = [ATTN_WIDTH, KV_WIDTH, KV_WIDTH, 3 * HYENA_WIDTH, NA_WIDTH, NA_WIDTH, NA_WIDTH]
    return jnp.split(p, np.cumsum(sizes)[:-1].tolist(), axis=-1)


def grid_rope_tables(n, dtype):
    t = jnp.arange(n, dtype=jnp.int32)
    rows = (t // GRID_W).astype(jnp.float32)
    cols = (t % GRID_W).astype(jnp.float32)
    nf = HEAD_DIM // 4
    inv = ROPE_THETA ** (-jnp.arange(nf, dtype=jnp.float32) / nf)
    ang = jnp.stack([rows[:, None] * inv, cols[:, None] * inv], axis=1)
    return jnp.cos(ang).astype(dtype), jnp.sin(ang).astype(dtype)


def axial_rope(x, cos, sin):
    xs = x.reshape(x.shape[:-1] + (2, 2, HEAD_DIM // 4))
    x1 = xs[..., 0, :]
    x2 = xs[..., 1, :]
    out = jnp.stack([x1 * cos - x2 * sin, x1 * sin + x2 * cos], axis=-2)
    return out.reshape(x.shape)


def dense_attention(q, k, v):
    s = jnp.einsum('bhgqd,bhkd->bhgqk', q, k).astype(jnp.float32) * (HEAD_DIM ** -0.5)
    p = jax.nn.softmax(s, axis=-1).astype(v.dtype)
    return jnp.einsum('bhgqk,bhkd->bhgqd', p, v)


def gqa_latent(q, k, v, kc, vc):
    b, hkv, g, s, dh = q.shape
    k_all = jnp.concatenate([kc, k], axis=2)
    v_all = jnp.concatenate([vc, v], axis=2)
    nb = s // Q_BLOCK
    qb = jnp.moveaxis(q.reshape(b, hkv, g, nb, Q_BLOCK, dh), 3, 0)
    o = lax.map(lambda qblk: dense_attention(qblk, k_all, v_all), qb)
    return jnp.moveaxis(o, 0, 3).reshape(b, hkv, g, s, dh)


def neighbourhood_attention(q, k, v, kc, vc, rpb):
    b, h, s, dh = q.shape
    rows = s // GRID_W
    nr = min(NA_ROWS, rows)
    kg = k.reshape(b, h, rows, GRID_W, dh)
    vg = v.reshape(b, h, rows, GRID_W, dh)
    q_rows = jnp.moveaxis(q.reshape(b, h, rows, GRID_W, dh), 2, 0)
    cols = jnp.arange(GRID_W)
    col_start = jnp.clip(cols - NA_COLS // 2, 0, GRID_W - NA_COLS)
    col_idx = col_start[:, None] + jnp.arange(NA_COLS)[None, :]
    rpb_cols = rpb[:, :, col_idx - cols[:, None] + NA_COLS - 1]
    scale = HEAD_DIM ** -0.5
    n_nb = nr * NA_COLS

    def row_block(args):
        r, q_row = args
        rs = jnp.clip(r - NA_ROWS // 2, 0, rows - nr)
        k_sel = lax.dynamic_slice_in_dim(kg, rs, nr, axis=2)[:, :, :, col_idx]
        v_sel = lax.dynamic_slice_in_dim(vg, rs, nr, axis=2)[:, :, :, col_idx]
        row_off = rs + jnp.arange(nr) - r + NA_ROWS - 1
        bias = jnp.take(rpb_cols, row_off, axis=1).transpose(0, 2, 1, 3)
        s_nb = jnp.einsum('bhqd,bhrqcd->bhqrc', q_row, k_sel).astype(jnp.float32) * scale
        s_nb = (s_nb + bias[None].astype(jnp.float32)).reshape(b, h, GRID_W, n_nb)
        s_ctx = jnp.einsum('bhqd,bhkd->bhqk', q_row, kc).astype(jnp.float32) * scale
        p = jax.nn.softmax(jnp.concatenate([s_nb, s_ctx], axis=-1), axis=-1).astype(v.dtype)
        p_nb = p[..., :n_nb].reshape(b, h, GRID_W, nr, NA_COLS)
        return (jnp.einsum('bhqrc,bhrqcd->bhqd', p_nb, v_sel)
                + jnp.einsum('bhqk,bhkd->bhqd', p[..., n_nb:], vc))

    o = lax.map(row_block, (jnp.arange(rows, dtype=jnp.int32), q_rows))
    return jnp.moveaxis(o, 0, 2).reshape(b, h, s, dh)


def implicit_filters(n, w1, b1, w2, b2, w3, freq):
    pos = jnp.arange(n, dtype=jnp.float32)
    t = pos / max(n - 1, 1)
    bands = jnp.linspace(1e-4, FILTER_BANDS - 1, FILTER_BANDS, dtype=jnp.float32)
    ang = (2.0 * math.pi / n) * pos[:, None] * bands[None, :]
    feats = jnp.concatenate([t[:, None], jnp.cos(ang), -jnp.sin(ang)], axis=-1)
    hdn = jnp.sin(freq * (feats @ w1 + b1))
    hdn = jnp.sin(freq * (hdn @ w2 + b2))
    filt = (hdn @ w3).astype(jnp.float32).reshape(n, 2, HYENA_WIDTH)
    deltas = jnp.linspace(math.log(DECAY_TARGET) / SLOW_DECAY_PCT, math.log(DECAY_TARGET) / FAST_DECAY_PCT,
                          HYENA_WIDTH, dtype=jnp.float32)
    decay = jnp.exp(-t[:, None] * jnp.abs(deltas)[None, :])
    return filt * decay[:, None, :]


def hyena_mixer(u, conv_w, conv_b, w1, b1, w2, b2, w3, freq, skip):
    b, n, ch = u.shape
    uc = lax.conv_general_dilated(u, conv_w[:, None, :], window_strides=(1,), padding=[(1, 1)],
                                  dimension_numbers=('NWC', 'WIO', 'NWC'), feature_group_count=ch) + conv_b
    x0, x1, v = jnp.split(uc, 3, axis=-1)
    filt = implicit_filters(n, w1, b1, w2, b2, w3, freq)
    k = jnp.concatenate([filt[:, 0], jnp.zeros((1, HYENA_WIDTH), jnp.float32), filt[:0:-1, 1]], axis=0)
    k = k / jnp.sum(jnp.abs(k), axis=0, keepdims=True)
    z = (v * x1).astype(jnp.float32)
    y = jnp.fft.irfft(jnp.fft.rfft(z, n=2 * n, axis=1) * jnp.fft.rfft(k, n=2 * n, axis=0)[None],
                      n=2 * n, axis=1)[:, :n]
    y = y + z * skip.astype(jnp.float32)
    return y.astype(u.dtype) * x0


def setup_inputs(seed: int = 0) -> dict:
    key = jax.random.key(seed)
    keys = iter(jax.random.split(key, 40))
    D = D_MODEL

    def nrm(shape, s):
        return jax.random.normal(next(keys), shape, jnp.float32) * s

    return {
        'x': nrm((BATCH, SEQ, D), 1.0),
        'c': nrm((BATCH, D), 1.0),
        'ctx': nrm((BATCH, CTX_LEN, D), 1.0),
        'c_ctx': nrm((D,), 1.0),
        'w_ada': nrm((DEPTH, D, N_MOD * D), 0.5 * D ** -0.5),
        'b_ada': nrm((DEPTH, N_MOD * D), 0.01),
        'g_ffn1': 1.0 + nrm((DEPTH, D), 0.02),
        'w_ffn1_gate': nrm((DEPTH, D, FFN_HIDDEN), D ** -0.5),
        'w_ffn1_up': nrm((DEPTH, D, FFN_HIDDEN), D ** -0.5),
        'w_ffn1_down': nrm((DEPTH, FFN_HIDDEN, D), FFN_HIDDEN ** -0.5),
        'g_mix': 1.0 + nrm((DEPTH, D), 0.02),
        'w_in': nrm((DEPTH, D, IN_WIDTH), D ** -0.5),
        'w_out': nrm((DEPTH, MIX_WIDTH, D), MIX_WIDTH ** -0.5),
        'g_q_attn': 1.0 + nrm((DEPTH, HEAD_DIM), 0.02),
        'g_k_attn': 1.0 + nrm((DEPTH, HEAD_DIM), 0.02),
        'conv_w': nrm((DEPTH, SHORT_CONV, 3 * HYENA_WIDTH), SHORT_CONV ** -0.5),
        'conv_b': nrm((DEPTH, 3 * HYENA_WIDTH), 0.01),
        'filt_w1': nrm((DEPTH, FILTER_EMB, FILTER_HIDDEN), FILTER_EMB ** -0.5),
        'filt_b1': nrm((DEPTH, FILTER_HIDDEN), 0.02),
        'filt_w2': nrm((DEPTH, FILTER_HIDDEN, FILTER_HIDDEN), FILTER_HIDDEN ** -0.5),
        'filt_b2': nrm((DEPTH, FILTER_HIDDEN), 0.02),
        'filt_w3': nrm((DEPTH, FILTER_HIDDEN, 2 * HYENA_WIDTH), FILTER_HIDDEN ** -0.5),
        'filt_freq': 1.0 + nrm((DEPTH, FILTER_HIDDEN), 0.02),
        'hyena_skip': nrm((DEPTH, HYENA_WIDTH), 1.0),
        'g_q_na': 1.0 + nrm((DEPTH, HEAD_DIM), 0.02),
        'g_k_na': 1.0 + nrm((DEPTH, HEAD_DIM), 0.02),
        'na_rpb': nrm((DEPTH, NA_HEADS, 2 * NA_ROWS - 1, 2 * NA_COLS - 1), 0.1),
        'g_ffn2': 1.0 + nrm((DEPTH, D), 0.02),
        'w_ffn2_gate': nrm((DEPTH, D, FFN_HIDDEN), D ** -0.5),
        'w_ffn2_up': nrm((DEPTH, D, FFN_HIDDEN), D ** -0.5),
        'w_ffn2_down': nrm((DEPTH, FFN_HIDDEN, D), FFN_HIDDEN ** -0.5),
    }


def reference(x, c, ctx, c_ctx, w_ada, b_ada, g_ffn1, w_ffn1_gate, w_ffn1_up, w_ffn1_down, g_mix, w_in, w_out,
              g_q_attn, g_k_attn, conv_w, conv_b, filt_w1, filt_b1, filt_w2, filt_b2, filt_w3, filt_freq,
              hyena_skip, g_q_na, g_k_na, na_rpb, g_ffn2, w_ffn2_gate, w_ffn2_up, w_ffn2_down):
    b, s, _ = x.shape
    n_ctx = ctx.shape[1]
    cos, sin = grid_rope_tables(s, x.dtype)
    h, hc = x, ctx
    for l in range(DEPTH):
        last = l == DEPTH - 1
        sh1, sc1, gt1, sh2, sc2, gt2, sh3, sc3, gt3 = [m[:, None, :] for m in adaln_params(c, w_ada[l], b_ada[l])]
        csh1, csc1, cgt1, csh2, csc2, cgt2, csh3, csc3, cgt3 = adaln_params(c_ctx, w_ada[l], b_ada[l])
        ffn1 = (w_ffn1_gate[l], w_ffn1_up[l], w_ffn1_down[l])
        ffn2 = (w_ffn2_gate[l], w_ffn2_up[l], w_ffn2_down[l])
        filt = (filt_w1[l], filt_b1[l], filt_w2[l], filt_b2[l], filt_w3[l], filt_freq[l], hyena_skip[l])

        h = h + 0.5 * gt1 * swiglu(modulate(rms_norm(h, g_ffn1[l]), sh1, sc1), *ffn1)
        hc = hc + 0.5 * cgt1 * swiglu(modulate(rms_norm(hc, g_ffn1[l]), csh1, csc1), *ffn1)

        px = modulate(rms_norm(h, g_mix[l]), sh2, sc2) @ w_in[l]
        pc = modulate(rms_norm(hc, g_mix[l]), csh2, csc2) @ w_in[l]
        aq, ak, av, hy, nq, nk, nv = split_proj(px)
        caq, cak, cav, chy, cnq, cnk, cnv = split_proj(pc)

        kca = rms_norm(to_heads(cak, ATTN_KV_HEADS), g_k_attn[l])
        vca = to_heads(cav, ATTN_KV_HEADS)
        kcn = rms_norm(to_heads(cnk, NA_HEADS), g_k_na[l])
        vcn = to_heads(cnv, NA_HEADS)

        qa = axial_rope(rms_norm(to_heads(aq, ATTN_HEADS), g_q_attn[l]), cos, sin)
        qa = qa.reshape(b, ATTN_KV_HEADS, GQA_GROUP, s, HEAD_DIM)
        ka = axial_rope(rms_norm(to_heads(ak, ATTN_KV_HEADS), g_k_attn[l]), cos, sin)
        ya = gqa_latent(qa, ka, to_heads(av, ATTN_KV_HEADS), kca, vca)
        ya = from_heads(ya.reshape(b, ATTN_HEADS, s, HEAD_DIM))
        yb = hyena_mixer(hy, conv_w[l], conv_b[l], *filt)
        qn = rms_norm(to_heads(nq, NA_HEADS), g_q_na[l])
        kn = rms_norm(to_heads(nk, NA_HEADS), g_k_na[l])
        yc = from_heads(neighbourhood_attention(qn, kn, to_heads(nv, NA_HEADS), kcn, vcn, na_rpb[l]))

        h = h + gt2 * (jnp.concatenate([ya, yb, yc], axis=-1) @ w_out[l])
        h = h + 0.5 * gt3 * swiglu(modulate(rms_norm(h, g_ffn2[l]), sh3, sc3), *ffn2)

        if not last:
            qca = rms_norm(to_heads(caq, ATTN_HEADS), g_q_attn[l]).reshape(b, ATTN_KV_HEADS, GQA_GROUP, n_ctx, HEAD_DIM)
            yca = from_heads(dense_attention(qca, kca, vca).reshape(b, ATTN_HEADS, n_ctx, HEAD_DIM))
            ycb = hyena_mixer(chy, conv_w[l], conv_b[l], *filt)
            qcn = rms_norm(to_heads(cnq, NA_HEADS), g_q_na[l])[:, :, None]
            ycn = from_heads(dense_attention(qcn, kcn, vcn)[:, :, 0])
            hc = hc + cgt2 * (jnp.concatenate([yca, ycb, ycn], axis=-1) @ w_out[l])
            hc = hc + 0.5 * cgt3 * swiglu(modulate(rms_norm(hc, g_ffn2[l]), csh3, csc3), *ffn2)
    return h
```

```cpp
#include <hip/hip_runtime.h>
#include <cstdint>
#include <cstdio>

typedef unsigned short bf16_t;
typedef short bf16x8 __attribute__((ext_vector_type(8)));
typedef float f32x4 __attribute__((ext_vector_type(4)));
typedef unsigned u32x2 __attribute__((ext_vector_type(2)));
typedef unsigned u32x4 __attribute__((ext_vector_type(4)));

constexpr int D = 1024, BATCH = 2, SEQ = 8192, DEPTH = 4, CTX = 256, HD = 64;
constexpr int MLAT = BATCH * SEQ, MCTX = BATCH * CTX, MTOT = MLAT + MCTX;
constexpr int FF = 2816, INW = 2304, NMOD = 9, GRIDW = 64;
constexpr int KVLEN = CTX + SEQ;
constexpr float EPS = 1e-6f;
constexpr float LOG2E = 1.4426950408889634f;

constexpr size_t MiB = 1u << 20;
constexpr size_t al(size_t x) { return (x + 255) & ~(size_t)255; }
constexpr size_t WS_CTL = 0;
constexpr size_t WS_FNORM = 4096;
constexpr size_t WS_MOD = 1 * MiB;
constexpr size_t WS_WGU = 2 * MiB;
constexpr size_t WS_WD = WS_WGU + al((size_t)DEPTH * 2 * 2 * FF * D * 2);
constexpr size_t WS_WIN = WS_WD + al((size_t)DEPTH * 2 * D * FF * 2);
constexpr size_t WS_WOUT = WS_WIN + al((size_t)DEPTH * INW * D * 2);
constexpr size_t WS_HCTX = WS_WOUT + al((size_t)DEPTH * D * D * 2);
constexpr size_t WS_XN = WS_HCTX + al((size_t)MCTX * D * 4);
constexpr size_t WS_HID = WS_XN + al((size_t)MTOT * D * 2);
constexpr size_t WS_PX = WS_HID;
constexpr size_t WS_QA = WS_HID + al((size_t)MTOT * FF * 2);
constexpr size_t WS_KA = WS_QA + al((size_t)MTOT * 512 * 2);
constexpr size_t WS_VAT = WS_KA + al((size_t)BATCH * KVLEN * 128 * 2);
constexpr size_t WS_NQ = WS_VAT + al((size_t)BATCH * KVLEN * 128 * 2);
constexpr size_t WS_NK = WS_NQ + al((size_t)MTOT * 256 * 2);
constexpr size_t WS_NV = WS_NK + al((size_t)BATCH * KVLEN * 256 * 2);
constexpr size_t WS_Z = WS_NV + al((size_t)BATCH * KVLEN * 256 * 2);
constexpr size_t WS_ZC = WS_Z + al((size_t)BATCH * 256 * SEQ * 4);
constexpr size_t WS_X0 = WS_ZC + al((size_t)BATCH * 256 * CTX * 4);
constexpr size_t WS_YMIX = WS_X0 + al((size_t)MTOT * 256 * 4);
constexpr size_t WS_KF = WS_YMIX + al((size_t)MTOT * D * 2);
constexpr size_t WS_KFC = WS_KF + al((size_t)DEPTH * 256 * 16384 * 4);
constexpr size_t WS_END = WS_KFC + al((size_t)DEPTH * 256 * 512 * 4);

__device__ __forceinline__ unsigned f2bf(float f) { unsigned u = __builtin_bit_cast(unsigned, f); return (u + 0x7fffu + ((u >> 16) & 1u)) >> 16; }
__device__ __forceinline__ float bf2f(bf16_t b) { return __builtin_bit_cast(float, (unsigned)b << 16); }
__device__ __forceinline__ unsigned pk2(float lo, float hi) { return f2bf(lo) | (f2bf(hi) << 16); }
__device__ __forceinline__ float wave_sum(float v) {
#pragma unroll
    for (int o = 1; o < 64; o <<= 1) v += __shfl_xor(v, o);
    return v;
}
__device__ __forceinline__ float wave_max(float v) {
#pragma unroll
    for (int o = 1; o < 64; o <<= 1) v = fmaxf(v, __shfl_xor(v, o));
    return v;
}
__device__ __forceinline__ float silu_f(float x) { return x / (1.f + __expf(-x)); }
__device__ __forceinline__ int mod_of_row(int row) { return row < SEQ ? 0 : (row < MLAT ? 1 : 2); }

__global__ __launch_bounds__(256) void k_transpose_cvt(const float* __restrict__ W, int K, int N, bf16_t* __restrict__ WT, int mode) {
    __shared__ float tile[32][33];
    const int tx = threadIdx.x & 31, ty = threadIdx.x >> 5;
    const int n0 = blockIdx.x * 32, k0 = blockIdx.y * 32;
#pragma unroll
    for (int i = 0; i < 4; ++i) tile[ty + 8 * i][tx] = W[(size_t)(k0 + ty + 8 * i) * N + n0 + tx];
    __syncthreads();
#pragma unroll
    for (int i = 0; i < 4; ++i) {
        const int n = n0 + ty + 8 * i;
        const int r = mode == 0 ? n : ((n >> 7) * 256 + (n & 127) + (mode == 2 ? 128 : 0));
        WT[(size_t)r * K + k0 + tx] = (bf16_t)f2bf(tile[tx][ty + 8 * i]);
    }
}

__global__ __launch_bounds__(256) void k_adaln(const float* __restrict__ c, const float* __restrict__ cctx, const float* __restrict__ w, const float* __restrict__ b, float* __restrict__ mod) {
    __shared__ float sc[3][D];
    for (int i = threadIdx.x; i < D; i += 256) { sc[0][i] = silu_f(c[i]); sc[1][i] = silu_f(c[D + i]); sc[2][i] = silu_f(cctx[i]); }
    __syncthreads();
    const int l = blockIdx.y, j = blockIdx.x * 256 + threadIdx.x;
    const float* wl = w + (size_t)l * D * (NMOD * D) + j;
    float s0 = 0.f, s1 = 0.f, s2 = 0.f;
    for (int k = 0; k < D; ++k) { const float wv = wl[(size_t)k * (NMOD * D)]; s0 += sc[0][k] * wv; s1 += sc[1][k] * wv; s2 += sc[2][k] * wv; }
    const float bv = b[(size_t)l * NMOD * D + j];
    float* m = mod + (size_t)l * 3 * NMOD * D;
    m[j] = s0 + bv; m[NMOD * D + j] = s1 + bv; m[2 * NMOD * D + j] = s2 + bv;
}

__global__ __launch_bounds__(256) void k_filter(const float* __restrict__ w1, const float* __restrict__ b1, const float* __restrict__ w2, const float* __restrict__ b2,
                                               const float* __restrict__ w3, const float* __restrict__ freq, float* __restrict__ KF, float* __restrict__ KFC, float* __restrict__ fnorm) {
    __shared__ float feats[64][33];
    __shared__ float h1[64][65];
    __shared__ float h2[64][65];
    const int l = blockIdx.y;
    int pb = blockIdx.x;
    const bool isctx = pb >= SEQ / 64;
    const int n = isctx ? CTX : SEQ;
    if (isctx) pb -= SEQ / 64;
    const int lane = threadIdx.x & 63, w = __builtin_amdgcn_readfirstlane(threadIdx.x >> 6);
    const int p = pb * 64 + lane;
    const float t = (float)p / (float)(n - 1);
    if (w == 0) {
        feats[lane][0] = t;
        for (int i = 0; i < 16; ++i) {
            const float band = 1e-4f + (float)i * ((15.0f - 1e-4f) / 15.0f);
            const float ang = (6.283185307179586f / (float)n) * (float)p * band;
            feats[lane][1 + i] = cosf(ang); feats[lane][17 + i] = -sinf(ang);
        }
    }
    __syncthreads();
    const float* W1 = w1 + (size_t)l * 33 * 64; const float* B1 = b1 + l * 64; const float* W2 = w2 + (size_t)l * 64 * 64; const float* B2 = b2 + l * 64;
    const float* W3 = w3 + (size_t)l * 64 * 512; const float* FR = freq + l * 64;
    {
        float acc[16];
#pragma unroll
        for (int j = 0; j < 16; ++j) acc[j] = B1[16 * w + j];
        for (int k = 0; k < 33; ++k) { const float f = feats[lane][k];
#pragma unroll
            for (int j = 0; j < 16; ++j) acc[j] += f * W1[k * 64 + 16 * w + j]; }
#pragma unroll
        for (int j = 0; j < 16; ++j) h1[lane][16 * w + j] = sinf(FR[16 * w + j] * acc[j]);
    }
    __syncthreads();
    {
        float acc[16];
#pragma unroll
        for (int j = 0; j < 16; ++j) acc[j] = B2[16 * w + j];
        for (int k = 0; k < 64; ++k) { const float f = h1[lane][k];
#pragma unroll
            for (int j = 0; j < 16; ++j) acc[j] += f * W2[k * 64 + 16 * w + j]; }
#pragma unroll
        for (int j = 0; j < 16; ++j) h2[lane][16 * w + j] = sinf(FR[16 * w + j] * acc[j]);
    }
    __syncthreads();
    const float dlo = logf(1e-2f) / 1.5f, dhi = logf(1e-2f) / 0.3f;
    for (int cg = 0; cg < 8; ++cg) {
        const int col0 = 128 * w + 16 * cg;
        float acc[16];
#pragma unroll
        for (int j = 0; j < 16; ++j) acc[j] = 0.f;
        for (int k = 0; k < 64; ++k) { const float f = h2[lane][k];
#pragma unroll
            for (int j = 0; j < 16; ++j) acc[j] += f * W3[k * 512 + col0 + j]; }
#pragma unroll
        for (int j = 0; j < 16; ++j) {
            const int col = col0 + j, dir = col >> 8, c = col & 255;
            const float delta = dlo + (dhi - dlo) * ((float)c / 255.0f);
            float v = acc[j] * __expf(-t * fabsf(delta));
            if (dir == 1 && p == 0) v = 0.f;
            const int lag = dir == 0 ? p : -p;
            if (!(dir == 1 && p == 0)) {
                if (isctx) KFC[((size_t)l * 256 + c) * 512 + lag + CTX] = v; else KF[((size_t)l * 256 + c) * 16384 + lag + SEQ] = v;
            }
            const float s = wave_sum(fabsf(v));
            if (lane == 0) atomicAdd(&fnorm[(l * 2 + (isctx ? 1 : 0)) * 256 + c], s);
        }
    }
}

__global__ __launch_bounds__(256) void k_norm(const float* __restrict__ hlat, const float* __restrict__ hctx, const float* __restrict__ g, const float* __restrict__ mod  , int shift_idx, bf16_t* __restrict__ XN) {
    const int row = blockIdx.x * 4 + (threadIdx.x >> 6), lane = threadIdx.x & 63;
    const float* src = row < MLAT ? hlat + (size_t)row * D : hctx + (size_t)(row - MLAT) * D;
    const float* m = mod + (size_t)mod_of_row(row) * NMOD * D;
    const float* sh = m + shift_idx * D; const float* sc = m + (shift_idx + 1) * D;
    f32x4 v[4]; float ss = 0.f;
#pragma unroll
    for (int j = 0; j < 4; ++j) { v[j] = *(const f32x4*)(src + 256 * j + 4 * lane); ss += v[j].x * v[j].x + v[j].y * v[j].y + v[j].z * v[j].z + v[j].w * v[j].w; }
    const float rstd = 1.0f / sqrtf(wave_sum(ss) * (1.f / D) + EPS);
#pragma unroll
    for (int j = 0; j < 4; ++j) {
        const int c0 = 256 * j + 4 * lane;
        const f32x4 gv = *(const f32x4*)(g + c0), sv = *(const f32x4*)(sc + c0), hv = *(const f32x4*)(sh + c0);
        const float a = v[j].x * rstd * gv.x * (1.f + sv.x) + hv.x, b = v[j].y * rstd * gv.y * (1.f + sv.y) + hv.y;
        const float c = v[j].z * rstd * gv.z * (1.f + sv.z) + hv.z, d = v[j].w * rstd * gv.w * (1.f + sv.w) + hv.w;
        u32x2 o; o.x = pk2(a, b); o.y = pk2(c, d);
        *(u32x2*)(XN + (size_t)row * D + c0) = o;
    }
}

struct GemmArgs { const bf16_t* A; const bf16_t* Bt; int M, N, K; bf16_t* O; int ldc; float* hlat; float* hctx; const float* mod; int gate_idx; float gscale; };
template <int EPI> __global__ __launch_bounds__(256) void k_gemm(GemmArgs g) {
    const int lane = threadIdx.x & 63, w = threadIdx.x >> 6, fr = lane & 15, fq = lane >> 4;
    const int m0 = blockIdx.y * 128 + (w >> 1) * 64;
    const int K = g.K;
    int brow[4];
    int ocol0;
    if (EPI == 1) {
        const int hc0 = blockIdx.x * 64 + (w & 1) * 32; ocol0 = hc0;
        const int base = (hc0 >> 7) * 256 + (hc0 & 127);
#pragma unroll
        for (int j = 0; j < 4; ++j) brow[j] = base + (j & 1) * 16 + (j >> 1) * 128 + fr;
    } else {
        const int n0 = blockIdx.x * 128 + (w & 1) * 64; ocol0 = n0;
#pragma unroll
        for (int j = 0; j < 4; ++j) brow[j] = n0 + 16 * j + fr;
    }
    f32x4 acc[4][4];
#pragma unroll
    for (int i = 0; i < 4; ++i)
#pragma unroll
        for (int j = 0; j < 4; ++j) acc[i][j] = (f32x4){0.f, 0.f, 0.f, 0.f};
    const bf16_t* Ap = g.A + (size_t)(m0 + fr) * K + 8 * fq;
    for (int k0 = 0; k0 < K; k0 += 32) {
        bf16x8 a[4], b[4];
#pragma unroll
        for (int i = 0; i < 4; ++i) a[i] = *(const bf16x8*)(Ap + (size_t)(16 * i) * K + k0);
#pragma unroll
        for (int j = 0; j < 4; ++j) b[j] = *(const bf16x8*)(g.Bt + (size_t)brow[j] * K + k0 + 8 * fq);
#pragma unroll
        for (int i = 0; i < 4; ++i)
#pragma unroll
            for (int j = 0; j < 4; ++j) acc[i][j] = __builtin_amdgcn_mfma_f32_16x16x32_bf16(b[j], a[i], acc[i][j], 0, 0, 0);
    }
#pragma unroll
    for (int i = 0; i < 4; ++i) {
        const int row = m0 + 16 * i + fr;
        if (EPI == 0) {
#pragma unroll
            for (int j = 0; j < 4; ++j) { u32x2 o; o.x = pk2(acc[i][j].x, acc[i][j].y); o.y = pk2(acc[i][j].z, acc[i][j].w); *(u32x2*)(g.O + (size_t)row * g.ldc + ocol0 + 16 * j + 4 * fq) = o; }
        } else if (EPI == 1) {
#pragma unroll
            for (int j = 0; j < 2; ++j) { const f32x4 gt = acc[i][j], up = acc[i][j + 2];
                u32x2 o; o.x = pk2(silu_f(gt.x) * up.x, silu_f(gt.y) * up.y); o.y = pk2(silu_f(gt.z) * up.z, silu_f(gt.w) * up.w);
                *(u32x2*)(g.O + (size_t)row * FF + ocol0 + 16 * j + 4 * fq) = o; }
        } else {
            float* hp = row < MLAT ? g.hlat + (size_t)row * D : g.hctx + (size_t)(row - MLAT) * D;
            const float* gt = g.mod + (size_t)mod_of_row(row) * NMOD * D + g.gate_idx * D;
#pragma unroll
            for (int j = 0; j < 4; ++j) { const int col = ocol0 + 16 * j + 4 * fq; const f32x4 gv = *(const f32x4*)(gt + col); f32x4 hv = *(f32x4*)(hp + col);
                hv.x += g.gscale * gv.x * acc[i][j].x; hv.y += g.gscale * gv.y * acc[i][j].y; hv.z += g.gscale * gv.z * acc[i][j].z; hv.w += g.gscale * gv.w * acc[i][j].w;
                *(f32x4*)(hp + col) = hv; }
        }
    }
}

struct PostArgs { const bf16_t* PX; const float *gqa, *gka, *gqn, *gkn, *convw, *convb; bf16_t *QA, *KA, *VAT, *NQ, *NK, *NV; float *Z, *ZC, *X0; };
__global__ __launch_bounds__(256) void k_post(PostArgs a) {
    const int row = blockIdx.x, lane = threadIdx.x & 63, w = threadIdx.x >> 6;
    const bool isctx = row >= MLAT;
    const int b = isctx ? (row - MLAT) / CTX : row / SEQ;
    const int t = isctx ? (row - MLAT) % CTX : row % SEQ;
    const int kvrow = isctx ? t : CTX + t;
    const bf16_t* px = a.PX + (size_t)row * INW;
    const int axis = lane >> 5, pair = (lane >> 4) & 1, f = lane & 15;
    const float pos = (float)(axis == 0 ? (t / GRIDW) : (t % GRIDW));
    const float inv = exp2f(-(float)f * (13.287712379549449f / 16.0f));
    float cs, sn; { const float ang = pos * inv; cs = cosf(ang); sn = sinf(ang); }
    for (int task = w; task < 28; task += 4) {
        if (task < 8) {
            const float v = bf2f(px[task * 64 + lane]);
            float y = v * (1.0f / sqrtf(wave_sum(v * v) * (1.f / 64.f) + EPS)) * a.gqa[lane];
            if (!isctx) { const float o = __shfl_xor(y, 16); y = pair == 0 ? y * cs - o * sn : o * sn + y * cs; }
            a.QA[(size_t)row * 512 + task * 64 + lane] = (bf16_t)f2bf(y * (0.125f * LOG2E));
        } else if (task < 10) {
            const int h = task - 8; const float v = bf2f(px[512 + h * 64 + lane]);
            float y = v * (1.0f / sqrtf(wave_sum(v * v) * (1.f / 64.f) + EPS)) * a.gka[lane];
            if (!isctx) { const float o = __shfl_xor(y, 16); y = pair == 0 ? y * cs - o * sn : o * sn + y * cs; }
            a.KA[((size_t)b * KVLEN + kvrow) * 128 + h * 64 + lane] = (bf16_t)f2bf(y);
        } else if (task < 12) {
            const int h = task - 10;
            a.VAT[(((size_t)b * 2 + h) * 64 + lane) * KVLEN + kvrow] = px[640 + h * 64 + lane];
        } else if (task < 16) {
            const int h = task - 12; const float v = bf2f(px[1536 + h * 64 + lane]);
            const float y = v * (1.0f / sqrtf(wave_sum(v * v) * (1.f / 64.f) + EPS)) * a.gqn[lane];
            a.NQ[(size_t)row * 256 + h * 64 + lane] = (bf16_t)f2bf(y);
        } else if (task < 20) {
            const int h = task - 16; const float v = bf2f(px[1792 + h * 64 + lane]);
            const float y = v * (1.0f / sqrtf(wave_sum(v * v) * (1.f / 64.f) + EPS)) * a.gkn[lane];
            a.NK[((size_t)b * KVLEN + kvrow) * 256 + h * 64 + lane] = (bf16_t)f2bf(y);
        } else if (task < 24) {
            const int h = task - 20;
            a.NV[((size_t)b * KVLEN + kvrow) * 256 + h * 64 + lane] = px[2048 + h * 64 + lane];
        } else {
            const int c = (task - 24) * 64 + lane; const int n = isctx ? CTX : SEQ;
            float r[3];
#pragma unroll
            for (int part = 0; part < 3; ++part) {
                const int ch = part * 256 + c;
                float s = a.convb[ch];
                if (t > 0) s += a.convw[ch] * bf2f(px[768 + ch - INW]);
                s += a.convw[768 + ch] * bf2f(px[768 + ch]);
                if (t < n - 1) s += a.convw[2 * 768 + ch] * bf2f(px[768 + ch + INW]);
                r[part] = s;
            }
            a.X0[(size_t)row * 256 + c] = r[0];
            const float z = r[2] * r[1];
            if (isctx) a.ZC[((size_t)b * 256 + c) * CTX + t] = z; else a.Z[((size_t)b * 256 + c) * SEQ + t] = z;
        }
    }
}

__global__ __launch_bounds__(256) void k_gqa(const bf16_t* __restrict__ QA, const bf16_t* __restrict__ KA, const bf16_t* __restrict__ VAT, bf16_t* __restrict__ Y, int qrow_base, int qrows_per_batch, int nkeys) {
    const int lane = threadIdx.x & 63, w = threadIdx.x >> 6, fr = lane & 15, g = lane >> 4;
    const int wq = blockIdx.x * 4 + w;
    const int h = blockIdx.y, b = blockIdx.z, kvh = h >> 2;
    const int qrow0 = qrow_base + b * qrows_per_batch + wq * 16;
    bf16x8 qf[2];
#pragma unroll
    for (int ks = 0; ks < 2; ++ks) qf[ks] = *(const bf16x8*)(QA + (size_t)(qrow0 + fr) * 512 + h * 64 + 32 * ks + 8 * g);
    const bf16_t* Kb = KA + (size_t)b * KVLEN * 128 + kvh * 64 + 8 * g;
    const bf16_t* Vb = VAT + ((size_t)b * 2 + kvh) * 64 * KVLEN + 8 * g;
    const int keyA = 8 * (fr >> 2) + (fr & 3);
    f32x4 o[4];
#pragma unroll
    for (int i = 0; i < 4; ++i) o[i] = (f32x4){0.f, 0.f, 0.f, 0.f};
    float mrun = -INFINITY, lrun = 0.f;
    for (int k0 = 0; k0 < nkeys; k0 += 32) {
        f32x4 sA = (f32x4){0.f, 0.f, 0.f, 0.f}, sB = sA;
#pragma unroll
        for (int ks = 0; ks < 2; ++ks) {
            const bf16x8 ka = *(const bf16x8*)(Kb + (size_t)(k0 + keyA) * 128 + 32 * ks);
            const bf16x8 kb = *(const bf16x8*)(Kb + (size_t)(k0 + keyA + 4) * 128 + 32 * ks);
            sA = __builtin_amdgcn_mfma_f32_16x16x32_bf16(ka, qf[ks], sA, 0, 0, 0);
            sB = __builtin_amdgcn_mfma_f32_16x16x32_bf16(kb, qf[ks], sB, 0, 0, 0);
        }
        float mx = fmaxf(fmaxf(fmaxf(sA.x, sA.y), fmaxf(sA.z, sA.w)), fmaxf(fmaxf(sB.x, sB.y), fmaxf(sB.z, sB.w)));
        mx = fmaxf(mx, __shfl_xor(mx, 16)); mx = fmaxf(mx, __shfl_xor(mx, 32));
        const float mnew = fmaxf(mrun, mx), alpha = exp2f(mrun - mnew);
        mrun = mnew;
        float p[8];
        p[0] = exp2f(sA.x - mnew); p[1] = exp2f(sA.y - mnew); p[2] = exp2f(sA.z - mnew); p[3] = exp2f(sA.w - mnew);
        p[4] = exp2f(sB.x - mnew); p[5] = exp2f(sB.y - mnew); p[6] = exp2f(sB.z - mnew); p[7] = exp2f(sB.w - mnew);
        lrun = lrun * alpha + ((p[0] + p[1]) + (p[2] + p[3])) + ((p[4] + p[5]) + (p[6] + p[7]));
        u32x4 pw; pw.x = pk2(p[0], p[1]); pw.y = pk2(p[2], p[3]); pw.z = pk2(p[4], p[5]); pw.w = pk2(p[6], p[7]);
        const bf16x8 pf = __builtin_bit_cast(bf16x8, pw);
#pragma unroll
        for (int dt = 0; dt < 4; ++dt) {
            o[dt] = o[dt] * alpha;
            const bf16x8 vf = *(const bf16x8*)(Vb + (size_t)(16 * dt + fr) * KVLEN + k0);
            o[dt] = __builtin_amdgcn_mfma_f32_16x16x32_bf16(vf, pf, o[dt], 0, 0, 0);
        }
    }
    lrun += __shfl_xor(lrun, 16); lrun += __shfl_xor(lrun, 32);
    const float il = 1.0f / lrun;
#pragma unroll
    for (int dt = 0; dt < 4; ++dt) { u32x2 ov; ov.x = pk2(o[dt].x * il, o[dt].y * il); ov.y = pk2(o[dt].z * il, o[dt].w * il);
        *(u32x2*)(Y + (size_t)(qrow0 + fr) * D + h * 64 + 16 * dt + 4 * g) = ov; }
}

__global__ __launch_bounds__(256) void k_na(const bf16_t* __restrict__ NQ, const bf16_t* __restrict__ NK, const bf16_t* __restrict__ NV, const float* __restrict__ rpb  , bf16_t* __restrict__ Y, int row_base) {
    const int lane = threadIdx.x & 63, h = threadIdx.x >> 6;
    const int row = row_base + blockIdx.x;
    const bool isctx = row >= MLAT;
    const int b = isctx ? (row - MLAT) / CTX : row / SEQ;
    const int t = isctx ? (row - MLAT) % CTX : row % SEQ;
    float q[64];
    {
        const bf16_t* qp = NQ + (size_t)row * 256 + h * 64;
#pragma unroll
        for (int i = 0; i < 8; ++i) { const bf16x8 v = *(const bf16x8*)(qp + 8 * i);
#pragma unroll
            for (int j = 0; j < 8; ++j) q[8 * i + j] = bf2f((bf16_t)v[j]); }
    }
    const bf16_t* Kb = NK + (size_t)b * KVLEN * 256 + h * 64;
    const bf16_t* Vb = NV + (size_t)b * KVLEN * 256 + h * 64;
    const int r = t / GRIDW, c = t % GRIDW;
    const int rs = min(max(r - 4, 0), SEQ / GRIDW - 8), cs = min(max(c - 8, 0), GRIDW - 16);
    float s[6]; int key[6];
#pragma unroll
    for (int i = 0; i < 6; ++i) {
        const int kk = lane + 64 * i;
        float bias = 0.f; int krow;
        if (i < 2) {
            const int ri = kk >> 4, ci = kk & 15;
            krow = CTX + (rs + ri) * GRIDW + cs + ci;
            bias = rpb[(h * 15 + (rs + ri - r + 7)) * 31 + (cs + ci - c + 15)];
        } else krow = kk - 128;
        key[i] = krow;
        float d = 0.f;
        const bf16_t* kp = Kb + (size_t)krow * 256;
#pragma unroll
        for (int u = 0; u < 8; ++u) { const bf16x8 v = *(const bf16x8*)(kp + 8 * u);
#pragma unroll
            for (int j = 0; j < 8; ++j) d += q[8 * u + j] * bf2f((bf16_t)v[j]); }
        s[i] = d * 0.125f + bias;
        if (isctx && i < 2) s[i] = -INFINITY;
    }
    float mx = s[0];
#pragma unroll
    for (int i = 1; i < 6; ++i) mx = fmaxf(mx, s[i]);
    mx = wave_max(mx);
    float sum = 0.f;
#pragma unroll
    for (int i = 0; i < 6; ++i) { s[i] = __expf(s[i] - mx); sum += s[i]; }
    sum = wave_sum(sum);
    const float inv = 1.0f / sum;
    float o = 0.f;
#pragma unroll
    for (int i = 0; i < 6; ++i) {
        if (isctx && i < 2) continue;
        for (int j = 0; j < 64; ++j) {
            const float pj = __shfl(s[i], j); const int kj = __shfl(key[i], j);
            o += pj * bf2f(Vb[(size_t)kj * 256 + lane]);
        }
    }
    Y[(size_t)row * D + 768 + h * 64 + lane] = (bf16_t)f2bf(o * inv);
}

__global__ __launch_bounds__(256) void k_hyena(const float* __restrict__ Z, const float* __restrict__ KF  , const float* __restrict__ fnorm  , const float* __restrict__ skip, const float* __restrict__ X0, bf16_t* __restrict__ Y) {
    __shared__ float zs[SEQ];
    const int c = blockIdx.x, b = blockIdx.y;
    const float* zp = Z + ((size_t)b * 256 + c) * SEQ;
    for (int i = threadIdx.x; i < SEQ; i += 256) zs[i] = zp[i];
    __syncthreads();
    const float* kf = KF + (size_t)c * 16384;
    const float inorm = 1.0f / fnorm[c], sk = skip[c];
    for (int pass = 0; pass < 4; ++pass) {
        const int t0 = 8 * (threadIdx.x + 256 * pass);
        float acc[8];
#pragma unroll
        for (int i = 0; i < 8; ++i) acc[i] = 0.f;
        float wv[15];
#pragma unroll
        for (int i = 0; i < 15; ++i) { const int idx = t0 + SEQ - 7 + i; wv[i] = (idx >= 1 && idx < 16384) ? kf[idx] : 0.f; }
        for (int s0 = 0; s0 < SEQ; s0 += 8) {
            float zv[8];
#pragma unroll
            for (int j = 0; j < 8; ++j) zv[j] = zs[s0 + j];
#pragma unroll
            for (int a2 = 0; a2 < 8; ++a2)
#pragma unroll
                for (int j = 0; j < 8; ++j) acc[a2] += wv[a2 - j + 7] * zv[j];
#pragma unroll
            for (int i = 14; i >= 8; --i) wv[i] = wv[i - 8];
            const int nb = t0 - (s0 + 8) + SEQ - 7;
#pragma unroll
            for (int i = 0; i < 8; ++i) { const int idx = nb + i; wv[i] = (idx >= 1 && idx < 16384) ? kf[idx] : 0.f; }
        }
#pragma unroll
        for (int i = 0; i < 8; ++i) {
            const int t = t0 + i; const size_t row = (size_t)b * SEQ + t;
            const float y = acc[i] * inorm + zs[t] * sk;
            Y[row * D + 512 + c] = (bf16_t)f2bf(y * X0[row * 256 + c]);
        }
    }
}
__global__ __launch_bounds__(256) void k_hyena_ctx(const float* __restrict__ ZC, const float* __restrict__ KFC  , const float* __restrict__ fnorm  , const float* __restrict__ skip, const float* __restrict__ X0, bf16_t* __restrict__ Y) {
    const int t = threadIdx.x, c = blockIdx.x, b = blockIdx.y;
    const float* zp = ZC + ((size_t)b * 256 + c) * CTX; const float* kf = KFC + (size_t)c * 512;
    float acc = 0.f;
    for (int s = 0; s < CTX; ++s) acc += kf[t - s + CTX] * zp[s];
    const size_t row = (size_t)MLAT + b * CTX + t;
    const float y = acc / fnorm[c] + zp[t] * skip[c];
    Y[row * D + 512 + c] = (bf16_t)f2bf(y * X0[row * 256 + c]);
}

__global__ __launch_bounds__(256) void k_copy4(const f32x4* __restrict__ src, f32x4* __restrict__ dst, size_t n4) {
    for (size_t i = (size_t)blockIdx.x * 256 + threadIdx.x; i < n4; i += (size_t)gridDim.x * 256) dst[i] = src[i];
}
__global__ __launch_bounds__(256) void k_zero_kf(float* KF, float* KFC) {
    const int i = blockIdx.x * 256 + threadIdx.x;
    if (i < DEPTH * 256) { KF[(size_t)i * 16384] = 0.f; KFC[(size_t)i * 512] = 0.f; }
}

extern "C" void kernel_launch(void* const* d_in, const int* in_sizes, int n_in, void* d_out, int out_size, void* d_ws, size_t ws_size, hipStream_t stream) {
    if (n_in != 31 || ws_size < WS_END) { fprintf(stderr, "kernel_launch: unexpected n_in %d or ws_size %zu < %zu\n", n_in, ws_size, (size_t)WS_END); return; }
    const float* x = (const float*)d_in[0]; const float* c = (const float*)d_in[1]; const float* ctx = (const float*)d_in[2]; const float* cctx = (const float*)d_in[3];
    const float* w_ada = (const float*)d_in[4]; const float* b_ada = (const float*)d_in[5];
    const float* g_ffn1 = (const float*)d_in[6]; const float* wg1 = (const float*)d_in[7]; const float* wu1 = (const float*)d_in[8]; const float* wd1 = (const float*)d_in[9];
    const float* g_mix = (const float*)d_in[10]; const float* w_in = (const float*)d_in[11]; const float* w_out = (const float*)d_in[12];
    const float* g_q_attn = (const float*)d_in[13]; const float* g_k_attn = (const float*)d_in[14]; const float* conv_w = (const float*)d_in[15]; const float* conv_b = (const float*)d_in[16];
    const float* fw1 = (const float*)d_in[17]; const float* fb1 = (const float*)d_in[18]; const float* fw2 = (const float*)d_in[19]; const float* fb2 = (const float*)d_in[20];
    const float* fw3 = (const float*)d_in[21]; const float* ffreq = (const float*)d_in[22]; const float* hskip = (const float*)d_in[23];
    const float* g_q_na = (const float*)d_in[24]; const float* g_k_na = (const float*)d_in[25]; const float* rpb = (const float*)d_in[26];
    const float* g_ffn2 = (const float*)d_in[27]; const float* wg2 = (const float*)d_in[28]; const float* wu2 = (const float*)d_in[29]; const float* wd2 = (const float*)d_in[30];
    unsigned char* ws = (unsigned char*)d_ws;
    float* hlat = (float*)d_out; float* hctx = (float*)(ws + WS_HCTX);
    float* mod = (float*)(ws + WS_MOD); float* fnorm = (float*)(ws + WS_FNORM);
    bf16_t* WGU = (bf16_t*)(ws + WS_WGU); bf16_t* WD = (bf16_t*)(ws + WS_WD); bf16_t* WIN = (bf16_t*)(ws + WS_WIN); bf16_t* WOUT = (bf16_t*)(ws + WS_WOUT);
    bf16_t* XN = (bf16_t*)(ws + WS_XN); bf16_t* HID = (bf16_t*)(ws + WS_HID); bf16_t* PX = (bf16_t*)(ws + WS_PX);
    bf16_t* QA = (bf16_t*)(ws + WS_QA); bf16_t* KA = (bf16_t*)(ws + WS_KA); bf16_t* VAT = (bf16_t*)(ws + WS_VAT);
    bf16_t* NQ = (bf16_t*)(ws + WS_NQ); bf16_t* NK = (bf16_t*)(ws + WS_NK); bf16_t* NV = (bf16_t*)(ws + WS_NV);
    float* Z = (float*)(ws + WS_Z); float* ZC = (float*)(ws + WS_ZC); float* X0 = (float*)(ws + WS_X0);
    bf16_t* YMIX = (bf16_t*)(ws + WS_YMIX); float* KF = (float*)(ws + WS_KF); float* KFC = (float*)(ws + WS_KFC);

    hipMemsetAsync(ws + WS_CTL, 0, 1 * MiB, stream);
    for (int l = 0; l < DEPTH; ++l) {
        for (int f = 0; f < 2; ++f) {
            const float* wg = (f == 0 ? wg1 : wg2) + (size_t)l * D * FF; const float* wu = (f == 0 ? wu1 : wu2) + (size_t)l * D * FF; const float* wd = (f == 0 ? wd1 : wd2) + (size_t)l * FF * D;
            bf16_t* gu = WGU + (size_t)(l * 2 + f) * 2 * FF * D; bf16_t* dn = WD + (size_t)(l * 2 + f) * D * FF;
            k_transpose_cvt<<<dim3(FF / 32, D / 32), 256, 0, stream>>>(wg, D, FF, gu, 1);
            k_transpose_cvt<<<dim3(FF / 32, D / 32), 256, 0, stream>>>(wu, D, FF, gu, 2);
            k_transpose_cvt<<<dim3(D / 32, FF / 32), 256, 0, stream>>>(wd, FF, D, dn, 0);
        }
        k_transpose_cvt<<<dim3(INW / 32, D / 32), 256, 0, stream>>>(w_in + (size_t)l * D * INW, D, INW, WIN + (size_t)l * INW * D, 0);
        k_transpose_cvt<<<dim3(D / 32, D / 32), 256, 0, stream>>>(w_out + (size_t)l * D * D, D, D, WOUT + (size_t)l * D * D, 0);
    }
    k_adaln<<<dim3(NMOD * D / 256, DEPTH), 256, 0, stream>>>(c, cctx, w_ada, b_ada, mod);
    k_zero_kf<<<4, 256, 0, stream>>>(KF, KFC);
    k_filter<<<dim3(SEQ / 64 + CTX / 64, DEPTH), 256, 0, stream>>>(fw1, fb1, fw2, fb2, fw3, ffreq, KF, KFC, fnorm);
    k_copy4<<<1024, 256, 0, stream>>>((const f32x4*)x, (f32x4*)hlat, (size_t)MLAT * D / 4);
    k_copy4<<<64, 256, 0, stream>>>((const f32x4*)ctx, (f32x4*)hctx, (size_t)MCTX * D / 4);

    for (int l = 0; l < DEPTH; ++l) {
        const float* modl = mod + (size_t)l * 3 * NMOD * D;
        const bool last = (l == DEPTH - 1);
        for (int f = 0; f < 2; ++f) {
            if (f == 1) {
                k_norm<<<MTOT / 4, 256, 0, stream>>>(hlat, hctx, g_mix + l * D, modl, 3, XN);
                { GemmArgs g{}; g.A = XN; g.Bt = WIN + (size_t)l * INW * D; g.M = MTOT; g.N = INW; g.K = D; g.O = PX; g.ldc = INW;
                  k_gemm<0><<<dim3(INW / 128, MTOT / 128), 256, 0, stream>>>(g); }
                { PostArgs a{}; a.PX = PX; a.gqa = g_q_attn + l * 64; a.gka = g_k_attn + l * 64; a.gqn = g_q_na + l * 64; a.gkn = g_k_na + l * 64; a.convw = conv_w + (size_t)l * 3 * 768; a.convb = conv_b + l * 768;
                  a.QA = QA; a.KA = KA; a.VAT = VAT; a.NQ = NQ; a.NK = NK; a.NV = NV; a.Z = Z; a.ZC = ZC; a.X0 = X0;
                  k_post<<<MTOT, 256, 0, stream>>>(a); }
                k_gqa<<<dim3(SEQ / 64, 8, BATCH), 256, 0, stream>>>(QA, KA, VAT, YMIX, 0, SEQ, KVLEN);
                k_na<<<MLAT, 256, 0, stream>>>(NQ, NK, NV, rpb + (size_t)l * 4 * 15 * 31, YMIX, 0);
                k_hyena<<<dim3(256, BATCH), 256, 0, stream>>>(Z, KF + (size_t)l * 256 * 16384, fnorm + (l * 2 + 0) * 256, hskip + l * 256, X0, YMIX);
                if (!last) {
                    k_gqa<<<dim3(CTX / 64, 8, BATCH), 256, 0, stream>>>(QA, KA, VAT, YMIX, MLAT, CTX, CTX);
                    k_na<<<MCTX, 256, 0, stream>>>(NQ, NK, NV, rpb + (size_t)l * 4 * 15 * 31, YMIX, MLAT);
                    k_hyena_ctx<<<dim3(256, BATCH), 256, 0, stream>>>(ZC, KFC + (size_t)l * 256 * 512, fnorm + (l * 2 + 1) * 256, hskip + l * 256, X0, YMIX);
                }
                const int Mo = last ? MLAT : MTOT;
                { GemmArgs g{}; g.A = YMIX; g.Bt = WOUT + (size_t)l * D * D; g.M = Mo; g.N = D; g.K = D; g.hlat = hlat; g.hctx = hctx; g.mod = modl; g.gate_idx = 5; g.gscale = 1.0f;
                  k_gemm<2><<<dim3(D / 128, Mo / 128), 256, 0, stream>>>(g); }
            }
            const int Mf = (last && f == 1) ? MLAT : MTOT;
            k_norm<<<Mf / 4, 256, 0, stream>>>(hlat, hctx, (f == 0 ? g_ffn1 : g_ffn2) + l * D, modl, f == 0 ? 0 : 6, XN);
            { GemmArgs g{}; g.A = XN; g.Bt = WGU + (size_t)(l * 2 + f) * 2 * FF * D; g.M = Mf; g.N = 2 * FF; g.K = D; g.O = HID; g.ldc = FF;
              k_gemm<1><<<dim3(FF / 64, Mf / 128), 256, 0, stream>>>(g); }
            { GemmArgs g{}; g.A = HID; g.Bt = WD + (size_t)(l * 2 + f) * D * FF; g.M = Mf; g.N = D; g.K = FF; g.hlat = hlat; g.hctx = hctx; g.mod = modl; g.gate_idx = f == 0 ? 2 : 8; g.gscale = 0.5f;
              k_gemm<2><<<dim3(D / 128, Mf / 128), 256, 0, stream>>>(g); }
        }
    }
}
```

```cpp
#include <hip/hip_runtime.h>
#include <cstdint>
#include <cstdio>
#include <hip/hip_cooperative_groups.h>
namespace cg = cooperative_groups;

typedef unsigned short bf16_t;
typedef short bf16x8 __attribute__((ext_vector_type(8)));
typedef float f32x4 __attribute__((ext_vector_type(4)));
typedef float f32x16 __attribute__((ext_vector_type(16)));
typedef unsigned u32x2 __attribute__((ext_vector_type(2)));
typedef unsigned u32x4 __attribute__((ext_vector_type(4)));

constexpr int D = 1024, BATCH = 2, SEQ = 8192, DEPTH = 4, CTX = 256, HD = 64;
constexpr int MLAT = BATCH * SEQ, MCTX = BATCH * CTX, MTOT = MLAT + MCTX;
constexpr int FF = 2816, INW = 2304, NMOD = 9, GRIDW = 64;
constexpr int KVLEN = CTX + SEQ;
constexpr float EPS = 1e-6f;
constexpr float LOG2E = 1.4426950408889634f;

constexpr size_t MiB = 1u << 20;
constexpr size_t al(size_t x) { return (x + 255) & ~(size_t)255; }
constexpr size_t WS_CTL = 0;
constexpr size_t WS_BAR = 16384;
constexpr size_t WS_QCTR = 32768;
constexpr size_t WS_FNORM = 4096;
constexpr size_t WS_MOD = 65536;
constexpr size_t WS_WGU = 2 * MiB;
constexpr size_t WS_WD = WS_WGU + al((size_t)DEPTH * 2 * 2 * FF * D * 2);
constexpr size_t WS_WIN = WS_WD + al((size_t)DEPTH * 2 * D * FF * 2);
constexpr size_t WS_WOUT = WS_WIN + al((size_t)DEPTH * INW * D * 2);
constexpr size_t WS_HCTX = WS_WOUT + al((size_t)DEPTH * D * D * 2);
constexpr size_t WS_XN = WS_HCTX + al((size_t)MCTX * D * 4);
constexpr size_t WS_HID = WS_XN + al((size_t)MTOT * D * 2);
constexpr size_t WS_PX = WS_HID;
constexpr size_t WS_QA = WS_HID + al((size_t)MTOT * FF * 2);
constexpr size_t WS_KA = WS_QA + al((size_t)MTOT * 512 * 2);
constexpr size_t WS_VAT = WS_KA + al((size_t)BATCH * KVLEN * 128 * 2);
constexpr size_t WS_NQ = WS_VAT + al((size_t)BATCH * KVLEN * 128 * 2);
constexpr size_t WS_NK = WS_NQ + al((size_t)MTOT * 256 * 2);
constexpr size_t WS_NV = WS_NK + al((size_t)BATCH * KVLEN * 256 * 2);
constexpr size_t WS_Z = WS_NV + al((size_t)BATCH * KVLEN * 256 * 2);
constexpr size_t WS_ZC = WS_Z + al((size_t)BATCH * 256 * SEQ * 4);
constexpr size_t WS_X0 = WS_ZC + al((size_t)BATCH * 256 * CTX * 4);
constexpr size_t WS_YMIX = WS_X0 + al((size_t)MTOT * 256 * 4);
constexpr size_t WS_KF = WS_YMIX + al((size_t)MTOT * D * 2);
constexpr size_t WS_KFC = WS_KF + al((size_t)DEPTH * 256 * 16384 * 4);
constexpr size_t WS_PART = WS_KFC + al((size_t)DEPTH * 256 * 512 * 4);
constexpr size_t WS_END = WS_PART + al((size_t)11 * MCTX * D * 4);

__device__ __forceinline__ unsigned f2bf(float f) { unsigned u = __builtin_bit_cast(unsigned, f); return (u + 0x7fffu + ((u >> 16) & 1u)) >> 16; }
__device__ __forceinline__ float bf2f(bf16_t b) { return __builtin_bit_cast(float, (unsigned)b << 16); }
typedef float f32x2_pk __attribute__((ext_vector_type(2))); typedef __bf16 bf16x2_pk __attribute__((ext_vector_type(2)));
__device__ __forceinline__ unsigned pk2(float lo, float hi) { f32x2_pk v = {lo, hi}; bf16x2_pk b = __builtin_convertvector(v, bf16x2_pk); return __builtin_bit_cast(unsigned, b); }
__device__ __forceinline__ float wave_sum(float v) {
#pragma unroll
    for (int o = 1; o < 64; o <<= 1) v += __shfl_xor(v, o);
    return v;
}
__device__ __forceinline__ float wave_max(float v) {
#pragma unroll
    for (int o = 1; o < 64; o <<= 1) v = fmaxf(v, __shfl_xor(v, o));
    return v;
}
__device__ __forceinline__ float fast_sin(float x) { float r = x * 0.15915494309189535f; r = r - floorf(r); return __builtin_amdgcn_sinf(r); }
__device__ __forceinline__ float silu_f(float x) { return x / (1.f + __expf(-x)); }
__device__ __forceinline__ int mod_of_row(int row) { return row < SEQ ? 0 : (row < MLAT ? 1 : 2); }

namespace pg8 {
#define PG8_LAS __attribute__((address_space(3)))
typedef unsigned short bf16_t;
typedef short bf16x8 __attribute__((ext_vector_type(8)));
typedef float f32x4 __attribute__((ext_vector_type(4)));
typedef unsigned u32x4 __attribute__((ext_vector_type(4)));
constexpr int BM = 256, BK = 64, HALF = 128, HTB = HALF * BK * 2  , STAGE_BYTES = 8 * HTB, NXCD = 8, WGM = 8;

__host__ __device__ __forceinline__ int lds_byte(int r, int c) { const int st = (r >> 4) * 2 + (c >> 5), rr = r & 15, cc = c & 31, ob = rr * 64 + cc * 2; return st * 1024 + (ob ^ (((ob >> 9) & 1) << 5)); }
__host__ __device__ __forceinline__ void stage_rc(int b, int& R, int& C) { const int st = b / 1024, sb = b % 1024, swz = sb ^ (((sb >> 9) & 1) << 5); R = (st >> 1) * 16 + swz / 64; C = (st & 1) * 32 + (swz % 64) / 2; }
__host__ __device__ __forceinline__ int perm32(int rho) { const int n = rho >> 4, i = rho & 15; return 8 * (i >> 2) + 4 * n + (i & 3); }

struct Unit { int pm, pn, ks; };
struct Gemm { const bf16_t* A; const bf16_t* Bt; int M, N, K, ld; };

struct StaticOrder {
    int nM, nN, nwg, G, c;
    __host__ __device__ void init(int M, int N, int G_, int c_) { nM = M / BM; nN = N / BM; nwg = nM * nN; G = G_; c = c_; }
    __host__ __device__ bool next(int i, Unit& u) const {
        const long L = (long)i * G + c; if (L >= nwg) return false;
        int wgid = (int)L; { const int q = nwg / NXCD, r = nwg % NXCD, xcd = wgid % NXCD, off = wgid / NXCD; wgid = (xcd < r ? xcd * (q + 1) : r * (q + 1) + (xcd - r) * q) + off; }
        const int nig = WGM * nN, gid = wgid / nig, fm = gid * WGM, gsz = (nM - fm) < WGM ? (nM - fm) : WGM;
        u.pm = fm + ((wgid % nig) % gsz); u.pn = (wgid % nig) / gsz; u.ks = 0; return true;
    }
    __device__ __forceinline__ void a_ready(const Unit&) const {}
    __device__ __forceinline__ void done(const Unit&) const {}
};

__device__ __forceinline__ unsigned cvt_pk_bf16(float lo, float hi) { unsigned r; asm volatile("v_cvt_pk_bf16_f32 %0, %1, %2" : "=v"(r) : "v"(lo), "v"(hi)); return r; }
struct EpiBf16 {
    static constexpr bool PERM = true, AFTER_DRAIN = false;
    bf16_t* O; int ldc;
    __device__ __forceinline__ void operator()(const f32x4 (&acc)[2][2][4][2], const Unit& u, int wr, int wc, int fr, int fq) const {
        const int row0 = u.pm * BM + wr * 64 + fr; const int col0 = u.pn * BM + wc * 32 + 8 * fq;
#pragma unroll
        for (int ai = 0; ai < 2; ++ai)
#pragma unroll
            for (int m = 0; m < 4; ++m) { bf16_t* rowp = O + (size_t)(row0 + ai * HALF + m * 16) * ldc + col0;
#pragma unroll
                for (int bj = 0; bj < 2; ++bj) { const f32x4 v0 = acc[ai][bj][m][0], v1 = acc[ai][bj][m][1];
                    u32x4 w; w.x = cvt_pk_bf16(v0[0], v0[1]); w.y = cvt_pk_bf16(v0[2], v0[3]); w.z = cvt_pk_bf16(v1[0], v1[1]); w.w = cvt_pk_bf16(v1[2], v1[3]);
                    *(u32x4*)(rowp + bj * HALF) = w; } }
    }
};
__device__ __forceinline__ float silu_e(float x) { return x * __builtin_amdgcn_rcpf(1.f + __builtin_amdgcn_exp2f(-1.4426950408889634f * x)); }
struct EpiSwiGLU {
    static constexpr bool PERM = true, AFTER_DRAIN = false;
    bf16_t* O; int ldc;
    __device__ __forceinline__ void operator()(const f32x4 (&acc)[2][2][4][2], const Unit& u, int wr, int wc, int fr, int fq) const {
        const int row0 = u.pm * BM + wr * 64 + fr; const int col0 = u.pn * HALF + wc * 32 + 8 * fq;
#pragma unroll
        for (int ai = 0; ai < 2; ++ai)
#pragma unroll
            for (int m = 0; m < 4; ++m) { bf16_t* rowp = O + (size_t)(row0 + ai * HALF + m * 16) * ldc + col0;
                const f32x4 g0 = acc[ai][0][m][0], g1 = acc[ai][0][m][1], u0 = acc[ai][1][m][0], u1 = acc[ai][1][m][1];
                u32x4 w; w.x = cvt_pk_bf16(silu_e(g0[0]) * u0[0], silu_e(g0[1]) * u0[1]); w.y = cvt_pk_bf16(silu_e(g0[2]) * u0[2], silu_e(g0[3]) * u0[3]);
                w.z = cvt_pk_bf16(silu_e(g1[0]) * u1[0], silu_e(g1[1]) * u1[1]); w.w = cvt_pk_bf16(silu_e(g1[2]) * u1[2], silu_e(g1[3]) * u1[3]);
                *(u32x4*)rowp = w; }
    }
};
struct SplitKOrder {
    int nunits, G, c, nks, nN, pm0;
    __host__ __device__ bool next(int i, Unit& u) const { const int L = i * G + c; if (L >= nunits) return false; u.ks = L % nks; const int tile = L / nks; u.pm = pm0 + tile / nN; u.pn = tile % nN; return true; }
    __device__ __forceinline__ void a_ready(const Unit&) const {}
    __device__ __forceinline__ void done(const Unit&) const {}
};
struct EpiResPart {
    static constexpr bool PERM = false, AFTER_DRAIN = true;
    float* part; const float* mod; int gate_idx; float gscale;
    __device__ __forceinline__ void fused(const f32x4 (&acc)[2][2][4][2], const Unit& u, int wr, int wc, int fr, int fq, PG8_LAS unsigned char*, int, int) const {
        const float* gt = mod + (size_t)2 * (9 * 1024) + gate_idx * 1024;
        const int col0 = u.pn * BM + wc * 32 + 4 * fq;
        float* base = part + ((size_t)u.ks * 512 + (size_t)(u.pm - 64) * BM + wr * 64 + fr) * 1024 + col0;
        f32x4 gv[2][2];
#pragma unroll
        for (int bj = 0; bj < 2; ++bj)
#pragma unroll
            for (int n = 0; n < 2; ++n) gv[bj][n] = *(const f32x4*)(gt + col0 + bj * HALF + n * 16) * gscale;
#pragma unroll
        for (int ai = 0; ai < 2; ++ai)
#pragma unroll
            for (int m = 0; m < 4; ++m) { float* p = base + (size_t)(ai * HALF + m * 16) * 1024;
#pragma unroll
                for (int bj = 0; bj < 2; ++bj)
#pragma unroll
                    for (int n = 0; n < 2; ++n) *(f32x4*)(p + bj * HALF + n * 16) = gv[bj][n] * acc[ai][bj][m][n]; }
    }
};
struct EpiRes {
    static constexpr bool PERM = false, AFTER_DRAIN = false;
    float* hlat; float* hctx; const float* mod; int gate_idx; float gscale;
    __device__ __forceinline__ void operator()(const f32x4 (&acc)[2][2][4][2], const Unit& u, int wr, int wc, int fr, int fq) const {
        const int mi = u.pm < 32 ? 0 : (u.pm < 64 ? 1 : 2);
        const float* gt = mod + (size_t)mi * (9 * 1024) + gate_idx * 1024;
        float* base = u.pm < 64 ? hlat + (size_t)u.pm * BM * 1024 : hctx + (size_t)(u.pm - 64) * BM * 1024;
        const int col0 = u.pn * BM + wc * 32 + 4 * fq;
#pragma unroll
        for (int bj = 0; bj < 2; ++bj)
#pragma unroll
            for (int n = 0; n < 2; ++n) { const f32x4 gv = *(const f32x4*)(gt + col0 + bj * HALF + n * 16) * gscale;
#pragma unroll
                for (int ai = 0; ai < 2; ++ai)
#pragma unroll
                    for (int m = 0; m < 4; ++m) { float* p = base + (size_t)(ai * HALF + wr * 64 + m * 16 + fr) * 1024 + col0 + bj * HALF + n * 16;
                        f32x4 hv = *(const f32x4*)p; hv = hv + gv * acc[ai][bj][m][n]; *(f32x4*)p = hv; } }
    }
};

template <class Epi, class Sched, bool ALIGN_EPI = false, bool SP2 = false>
__device__ __forceinline__ void gemm_phase(PG8_LAS unsigned char* lds, const Gemm g, const Sched& S, const Epi& E) {
    int tid_l = threadIdx.x; asm volatile("" : "+v"(tid_l));
    const int tid = tid_l, wid = __builtin_amdgcn_readfirstlane(tid >> 6), lane = tid & 63, wr = wid >> 2, wc = wid & 3, fr = lane & 15, fq = lane >> 4;
    const int K = g.K, nt = K / BK;
    unsigned voffA[2], voffB[2];
#pragma unroll
    for (int i = 0; i < 2; ++i) { int R, C; stage_rc(tid * 16 + i * 8192, R, C); const int Rb = Epi::PERM ? ((R & ~31) + perm32(R & 31)) : R;
        voffA[i] = (unsigned)(R * g.ld + C) * 2u; voffB[i] = (unsigned)(Rb * g.ld + C) * 2u; }
    const size_t kstep = (size_t)(BK * 2);
    const size_t hstep = (size_t)HALF * g.ld * 2; const size_t kslb = (size_t)K * 2;
    const size_t tstep = 2 * hstep;
    const unsigned ldsw = (unsigned)wid * 1024u;
    const int aoff = lds_byte(wr * 64 + fr, fq * 8), boff = lds_byte(wc * 32 + fr, fq * 8);
#define PG8_SA(b, h) (((b) * 2 + (h)) * HTB)
#define PG8_SB(b, h) ((4 + (b) * 2 + (h)) * HTB)
#define PG8_STAGE(bufoff, gbase, voff) do { _Pragma("unroll") for (int _i = 0; _i < 2; ++_i) \
        __builtin_amdgcn_global_load_lds((const unsigned*)((const char*)(gbase) + (voff)[_i]), (PG8_LAS unsigned*)(lds + (bufoff) + ldsw + _i * 8192), 16, 0, 0); } while (0)
#define PG8_LDA(dst, b, h) do { _Pragma("unroll") for (int m = 0; m < 4; ++m) _Pragma("unroll") for (int k = 0; k < 2; ++k) dst[m][k] = *(const PG8_LAS bf16x8*)(lds + PG8_SA(b, h) + aoff + m * 2048 + k * 1024); } while (0)
#define PG8_LDB(dst, b, h) do { _Pragma("unroll") for (int n = 0; n < 2; ++n) _Pragma("unroll") for (int k = 0; k < 2; ++k) dst[n][k] = *(const PG8_LAS bf16x8*)(lds + PG8_SB(b, h) + boff + n * 2048 + k * 1024); } while (0)
#define PG8_MMA(ai, bj, At, Bt) do { __builtin_amdgcn_s_setprio(1); _Pragma("unroll") for (int m = 0; m < 4; ++m) _Pragma("unroll") for (int n = 0; n < 2; ++n) _Pragma("unroll") for (int k = 0; k < 2; ++k) \
        acc[ai][bj][m][n] = __builtin_amdgcn_mfma_f32_16x16x32_bf16(Bt[n][k], At[m][k], acc[ai][bj][m][n], 0, 0, 0); __builtin_amdgcn_s_setprio(0); } while (0)
#define PG8_WAIT_V(n) asm volatile("s_waitcnt vmcnt(" #n ")" ::: "memory")
#define PG8_WAIT_L(n) asm volatile("s_waitcnt lgkmcnt(" #n ")" ::: "memory")
#define PG8_BAR __builtin_amdgcn_s_barrier()
#define PG8_SCHED __builtin_amdgcn_sched_barrier(0)
    Unit cur, nxt; int ui = 0;
    if (!S.next(0, cur)) return;
    f32x4 acc[2][2][4][2];
#pragma unroll
    for (int a = 0; a < 2; ++a)
#pragma unroll
        for (int b = 0; b < 2; ++b)
#pragma unroll
            for (int m = 0; m < 4; ++m)
#pragma unroll
                for (int n = 0; n < 2; ++n) acc[a][b][m][n] = (f32x4){0.f, 0.f, 0.f, 0.f};
    bf16x8 At[4][2], B0[2][2], B1[2][2];
    const char* cA = (const char*)g.A + (size_t)cur.pm * tstep + (size_t)cur.ks * kslb; const char* cB = (const char*)g.Bt + (size_t)cur.pn * tstep + (size_t)cur.ks * kslb;
    S.a_ready(cur);
    if constexpr (SP2) {
        PG8_STAGE(PG8_SB(0, 0), cB, voffB); PG8_STAGE(PG8_SB(0, 1), cB + hstep, voffB); PG8_STAGE(PG8_SA(0, 0), cA, voffA); PG8_STAGE(PG8_SA(0, 1), cA + hstep, voffA);
        if (wr == 1) PG8_BAR;
        PG8_WAIT_V(2); PG8_BAR;
        PG8_STAGE(PG8_SB(1, 0), cB + kstep, voffB); PG8_STAGE(PG8_SA(1, 0), cA + kstep, voffA); PG8_STAGE(PG8_SB(1, 1), cB + hstep + kstep, voffB);
        PG8_WAIT_V(6); PG8_BAR;
    } else {
        PG8_STAGE(PG8_SB(0, 0), cB, voffB); PG8_STAGE(PG8_SA(0, 0), cA, voffA); PG8_STAGE(PG8_SB(0, 1), cB + hstep, voffB); PG8_STAGE(PG8_SA(0, 1), cA + hstep, voffA);
        if (wr == 1) PG8_BAR;
        PG8_WAIT_V(4); PG8_BAR;
        PG8_STAGE(PG8_SB(1, 0), cB + kstep, voffB); PG8_STAGE(PG8_SA(1, 0), cA + kstep, voffA); PG8_STAGE(PG8_SB(1, 1), cB + hstep + kstep, voffB);
        PG8_WAIT_V(6); PG8_BAR;
    }
    for (;;) {
        const bool has_next = S.next(ui + 1, nxt);
        const char* nA = has_next ? (const char*)g.A + (size_t)nxt.pm * tstep + (size_t)nxt.ks * kslb : cA; const char* nB = has_next ? (const char*)g.Bt + (size_t)nxt.pn * tstep + (size_t)nxt.ks * kslb : cB;
        for (int t = 0; t < nt; t += 2) {
            const bool last = (t == nt - 2);
            const char* a1 = cA + (size_t)(t + 1) * kstep;
            const char* a2 = last ? nA : cA + (size_t)(t + 2) * kstep; const char* b2 = last ? nB : cB + (size_t)(t + 2) * kstep;
            const char* a3 = a2 + kstep; const char* b3 = b2 + kstep;
            if (last && has_next) S.a_ready(nxt);
            if constexpr (SP2) {
            PG8_LDB(B0, 0, 0); PG8_LDB(B1, 0, 1); PG8_SCHED; PG8_LDA(At, 0, 0); PG8_STAGE(PG8_SA(1, 1), a1 + hstep, voffA);
            PG8_WAIT_V(8); PG8_WAIT_L(0); PG8_BAR; PG8_MMA(0, 0, At, B0); PG8_MMA(0, 1, At, B1); PG8_BAR; PG8_SCHED;
            PG8_LDA(At, 0, 1); PG8_STAGE(PG8_SB(0, 0), b2, voffB); PG8_STAGE(PG8_SB(0, 1), b2 + hstep, voffB); PG8_STAGE(PG8_SA(0, 0), a2, voffA);
            PG8_WAIT_V(8); PG8_WAIT_L(0); PG8_BAR; PG8_MMA(1, 0, At, B0); PG8_MMA(1, 1, At, B1); PG8_BAR; PG8_SCHED;
            PG8_LDB(B0, 1, 0); PG8_LDB(B1, 1, 1); PG8_SCHED; PG8_LDA(At, 1, 0); PG8_STAGE(PG8_SA(0, 1), a2 + hstep, voffA);
            PG8_WAIT_V(8); PG8_WAIT_L(0); PG8_BAR; PG8_MMA(0, 0, At, B0); PG8_MMA(0, 1, At, B1); PG8_BAR; PG8_SCHED;
            PG8_LDA(At, 1, 1); PG8_STAGE(PG8_SB(1, 0), b3, voffB); PG8_STAGE(PG8_SB(1, 1), b3 + hstep, voffB); PG8_STAGE(PG8_SA(1, 0), a3, voffA);
            PG8_WAIT_V(8); PG8_WAIT_L(0); PG8_BAR; PG8_MMA(1, 0, At, B0); PG8_MMA(1, 1, At, B1); PG8_BAR; PG8_SCHED;
            } else {
            PG8_LDB(B0, 0, 0); PG8_SCHED; PG8_LDA(At, 0, 0); PG8_STAGE(PG8_SA(1, 1), a1 + hstep, voffA);
            PG8_WAIT_L(8); PG8_BAR; PG8_WAIT_L(0); PG8_MMA(0, 0, At, B0); PG8_BAR; PG8_SCHED;
            PG8_LDB(B1, 0, 1); PG8_STAGE(PG8_SB(0, 0), b2, voffB);
            PG8_BAR; PG8_WAIT_L(0); PG8_MMA(0, 1, At, B1); PG8_BAR;
            PG8_LDA(At, 0, 1); PG8_STAGE(PG8_SA(0, 0), a2, voffA);
            PG8_BAR; PG8_WAIT_L(0); PG8_MMA(1, 0, At, B0); PG8_BAR; PG8_SCHED;
            PG8_STAGE(PG8_SB(0, 1), b2 + hstep, voffB);
            PG8_WAIT_V(6); PG8_BAR; PG8_MMA(1, 1, At, B1); PG8_BAR;
            PG8_LDB(B0, 1, 0); PG8_SCHED; PG8_LDA(At, 1, 0); PG8_STAGE(PG8_SA(0, 1), a2 + hstep, voffA);
            PG8_WAIT_L(8); PG8_BAR; PG8_WAIT_L(0); PG8_MMA(0, 0, At, B0); PG8_BAR; PG8_SCHED;
            PG8_LDB(B1, 1, 1); PG8_STAGE(PG8_SB(1, 0), b3, voffB);
            PG8_BAR; PG8_WAIT_L(0); PG8_MMA(0, 1, At, B1); PG8_BAR;
            PG8_LDA(At, 1, 1); PG8_STAGE(PG8_SA(1, 0), a3, voffA);
            PG8_BAR; PG8_WAIT_L(0); PG8_MMA(1, 0, At, B0); PG8_BAR; PG8_SCHED;
            PG8_STAGE(PG8_SB(1, 1), b3 + hstep, voffB);
            PG8_WAIT_V(6); PG8_BAR; PG8_MMA(1, 1, At, B1); PG8_BAR;
            }
        }
        if constexpr (ALIGN_EPI) { if (wr == 0) PG8_BAR; }
        if constexpr (!Epi::AFTER_DRAIN) { E(acc, cur, wr, wc, fr, fq); S.done(cur); }
        if (!has_next) break;
#pragma unroll
        for (int a = 0; a < 2; ++a)
#pragma unroll
            for (int b = 0; b < 2; ++b)
#pragma unroll
                for (int m = 0; m < 4; ++m)
#pragma unroll
                    for (int n = 0; n < 2; ++n) acc[a][b][m][n] = (f32x4){0.f, 0.f, 0.f, 0.f};
        cur = nxt; cA = nA; cB = nB; ++ui;
        if constexpr (ALIGN_EPI) { if (wr == 1) PG8_BAR; }
    }
    PG8_WAIT_V(0);
    if constexpr (!ALIGN_EPI) { if (wr == 0) PG8_BAR; }
    PG8_BAR;
    if constexpr (Epi::AFTER_DRAIN) { E.fused(acc, cur, wr, wc, fr, fq, lds, wid, lane); S.done(cur); }
#undef PG8_SA
#undef PG8_SB
#undef PG8_STAGE
#undef PG8_LDA
#undef PG8_LDB
#undef PG8_MMA
#undef PG8_WAIT_V
#undef PG8_WAIT_L
#undef PG8_BAR
#undef PG8_SCHED
}
}
#include <hip/hip_bf16.h>
#include <cmath>
namespace attn_body {
using bf16=__hip_bfloat16;
using bf16x8=__attribute__((ext_vector_type(8)))short;
using s16x4=__attribute__((ext_vector_type(4)))short;
using f32x16=__attribute__((ext_vector_type(16)))float;
using u32x4=__attribute__((ext_vector_type(4)))unsigned;
constexpr int D=64,QP=512,KP=128,OP=1024;
constexpr int NW=8,QBLK=32,QB=QBLK*NW,KVBLK=64;
__device__ __forceinline__ int crow(int r,int hi){return (r&3)+8*(r>>2)+4*hi;}
#define SBAR() __builtin_amdgcn_sched_barrier(0)
constexpr int NSLOT=3, SLOTB=8192;
constexpr int LDS_K=0, LDS_V=NSLOT*SLOTB, LDS_WS=2*NSLOT*SLOTB, LDS_OST=LDS_WS+NW*64*4, LDS_BYTES=LDS_OST+NW*4096;
constexpr float C2=0.125f*1.4426950408889634f;
__device__ __forceinline__ void glds16(const void*gsrc,unsigned lds_dst){unsigned keep;
  asm volatile("s_mov_b32 %0, m0\n\ts_mov_b32 m0, %2\n\ts_nop 0\n\tglobal_load_lds_dwordx4 %1, off\n\ts_mov_b32 m0, %0":"=&s"(keep):"v"(gsrc),"s"(lds_dst):"memory");}
__device__ __forceinline__ float max3f(float a,float b,float c){float r;asm("v_max3_f32 %0, %1, %2, %3":"=v"(r):"v"(a),"v"(b),"v"(c));return r;}
__device__ __forceinline__ float max2f(float a,float b){float r;asm("v_max_f32_e32 %0, %1, %2":"=v"(r):"v"(a),"v"(b));return r;}
__device__ __forceinline__ float fadd_s(float a,float b){float r;asm("v_add_f32_e32 %0, %1, %2":"=v"(r):"v"(a),"v"(b));return r;}
__device__ __forceinline__ float fsub_s(float a,float b){float r;asm("v_sub_f32_e32 %0, %1, %2":"=v"(r):"v"(a),"v"(b));return r;}
typedef float f32x2_t __attribute__((ext_vector_type(2))); typedef __bf16 bf16x2_t __attribute__((ext_vector_type(2)));
__device__ __forceinline__ unsigned cvtpk_s(float lo,float hi){f32x2_t v={lo,hi};bf16x2_t b=__builtin_convertvector(v,bf16x2_t);return __builtin_bit_cast(unsigned,b);}
#define WAIT_BAR(N) asm volatile("s_waitcnt vmcnt(" #N ") lgkmcnt(0)\n\ts_barrier":::"memory")

__device__ __forceinline__ void qkt(f32x16&p0,f32x16&p1,const char*Kslot,const bf16x8*qr,const f32x16&negm,int r32,int hi){
  const char*kb=Kslot+hi*1024+r32*16;
  #pragma unroll
  for(int d0=0;d0<4;++d0){
    const bf16x8 b0=*reinterpret_cast<const bf16x8*>(kb+d0*2048);
    const bf16x8 b1=*reinterpret_cast<const bf16x8*>(kb+d0*2048+512);
    if(d0==0){p0=__builtin_amdgcn_mfma_f32_32x32x16_bf16(b0,qr[0],negm,0,0,0);p1=__builtin_amdgcn_mfma_f32_32x32x16_bf16(b1,qr[0],negm,0,0,0);}
    else{p0=__builtin_amdgcn_mfma_f32_32x32x16_bf16(b0,qr[d0],p0,0,0,0);p1=__builtin_amdgcn_mfma_f32_32x32x16_bf16(b1,qr[d0],p1,0,0,0);}}
}
typedef __attribute__((address_space(3))) const char* lds_cptr;
typedef short v4i16_t __attribute__((ext_vector_type(4)));
__device__ __forceinline__ void kload8(bf16x8*kf,lds_cptr kp){
  kf[0]=*(const __attribute__((address_space(3))) bf16x8*)(kp);      kf[1]=*(const __attribute__((address_space(3))) bf16x8*)(kp+512);
  kf[2]=*(const __attribute__((address_space(3))) bf16x8*)(kp+2048); kf[3]=*(const __attribute__((address_space(3))) bf16x8*)(kp+2560);
  kf[4]=*(const __attribute__((address_space(3))) bf16x8*)(kp+4096); kf[5]=*(const __attribute__((address_space(3))) bf16x8*)(kp+4608);
  kf[6]=*(const __attribute__((address_space(3))) bf16x8*)(kp+6144); kf[7]=*(const __attribute__((address_space(3))) bf16x8*)(kp+6656);
}
__device__ __forceinline__ void kload2(bf16x8*kf,lds_cptr kp,int j){ kf[2*j]=*(const __attribute__((address_space(3))) bf16x8*)(kp+j*2048); kf[2*j+1]=*(const __attribute__((address_space(3))) bf16x8*)(kp+j*2048+512); }
__device__ __forceinline__ s16x4 vtr(lds_cptr p){ return __builtin_bit_cast(s16x4,__builtin_amdgcn_ds_read_tr16_b64_v4i16((__attribute__((address_space(3))) v4i16_t*)p)); }
__device__ __forceinline__ float rowmax(const f32x16&p0,const f32x16&p1){
  float a=max3f(p0[0],p0[1],p1[0]),b=max3f(p0[2],p0[3],p1[1]);a=max3f(a,p1[2],p1[3]);
  #pragma unroll
  for(int r=4;r<16;r+=4){a=max3f(a,p0[r],p0[r+1]);b=max3f(b,p0[r+2],p0[r+3]);a=max3f(a,p1[r],p1[r+1]);b=max3f(b,p1[r+2],p1[r+3]);}
  const float m=max2f(a,b);
  auto rr=__builtin_amdgcn_permlane32_swap(__float_as_uint(m),__float_as_uint(m),false,false);
  return max2f(__uint_as_float(rr[0]),__uint_as_float(rr[1]));
}
__device__ __forceinline__ void pv(f32x16*o,int vb,bf16x8 pa0,bf16x8 pa1,bf16x8 pa2,bf16x8 pa3){
  #pragma unroll
  for(int d0=0;d0<2;++d0){s16x4 lo[4],hi[4];
    #pragma unroll
    for(int ks=0;ks<4;++ks){
      asm volatile("ds_read_b64_tr_b16 %0,%1 offset:%c2":"=&v"(lo[ks]):"v"(vb),"i"(d0*4096+ks*1024):"memory");
      asm volatile("ds_read_b64_tr_b16 %0,%1 offset:%c2":"=&v"(hi[ks]):"v"(vb),"i"(d0*4096+ks*1024+512):"memory");}
    asm volatile("s_waitcnt lgkmcnt(0)":::"memory");SBAR();
    #define PK(k) (bf16x8){lo[k][0],lo[k][1],lo[k][2],lo[k][3],hi[k][0],hi[k][1],hi[k][2],hi[k][3]}
    o[d0]=__builtin_amdgcn_mfma_f32_32x32x16_bf16(pa0,PK(0),o[d0],0,0,0);
    o[d0]=__builtin_amdgcn_mfma_f32_32x32x16_bf16(pa1,PK(1),o[d0],0,0,0);
    o[d0]=__builtin_amdgcn_mfma_f32_32x32x16_bf16(pa2,PK(2),o[d0],0,0,0);
    o[d0]=__builtin_amdgcn_mfma_f32_32x32x16_bf16(pa3,PK(3),o[d0],0,0,0);
    #undef PK
  }
}

#ifndef ATTN_STORE16
#define ATTN_STORE16(p,v) (*(u32x4*)(p)=(v))
#endif
template<int THRL> __device__ __forceinline__ void attn_unit(long qrow0,int h,long kvbase,int nkeys,const bf16*Q,const bf16*__restrict__ K,const bf16*__restrict__ V,bf16*O,char*shm){
  int tid=threadIdx.x; asm volatile("":"+v"(tid)); const int lane=tid&63,r32=lane&31,hi=lane>>5; const int wid=__builtin_amdgcn_readfirstlane(tid>>6);
  const bf16*Qw=Q+(qrow0+wid*QBLK)*QP+h*D;
  const bf16*Kh=K+kvbase*KP+(h>>2)*D,*Vh=V+kvbase*KP+(h>>2)*D;
  const unsigned lds0=(unsigned)(uintptr_t)shm;
  float*wsf=(float*)(shm+LDS_WS)+wid*64;
  const bf16*ksrc=Kh+(long)lane*KP+wid*8;
  const bf16*vsrc=Vh+(long)(16*(wid&3)+(lane>>2))*KP+(wid>>2)*32+(lane&3)*8;
  const unsigned kdst=lds0+LDS_K+wid*1024, vdst=lds0+LDS_V+wid*1024;
  #define DMA_K(t,slot) glds16(ksrc+(long)(t)*KVBLK*KP,(unsigned)__builtin_amdgcn_readfirstlane(kdst+(slot)))
  #define DMA_V(t,slot) glds16(vsrc+(long)(t)*KVBLK*KP,(unsigned)__builtin_amdgcn_readfirstlane(vdst+(slot)))
  const int vb0=(int)(lds0+LDS_V)+((lane>>4)&1)*32+(lane&3)*8+(4*hi+((lane&15)>>2))*64;
  const char*Kbase=shm+LDS_K; bf16x8 kf[8];
  const lds_cptr shm3=(lds_cptr)shm; const lds_cptr kp0=shm3+LDS_K+hi*1024+r32*16; const lds_cptr vp0=shm3+LDS_V+((lane>>4)&1)*32+(lane&3)*8+(4*hi+((lane&15)>>2))*64;
  const int NT=nkeys/KVBLK;
  DMA_K(0,0);DMA_V(0,0);DMA_K(1,SLOTB);
  bf16x8 qr[4];
  #pragma unroll
  for(int d0=0;d0<4;++d0)qr[d0]=*reinterpret_cast<const bf16x8*>(&Qw[(long)r32*QP+d0*16+hi*8]);
  float mhat=0.f,l_reg=0.f;f32x16 o[2];o[0]=f32x16{};o[1]=f32x16{};f32x16 negm=f32x16{};asm volatile("":"+v"(negm));
  #define CMASK(P0,P1,t) do{}while(0)
  bool resc=false;
  #define START(P0,P1) do{ const float rm=rowmax(P0,P1); resc=false; \
    { const float dl=rm; mhat=fadd_s(mhat,dl); \
      _Pragma("unroll") for(int r=0;r<16;++r){P0[r]=fsub_s(P0[r],dl);P1[r]=fsub_s(P1[r],dl);} \
      _Pragma("unroll") for(int r=0;r<16;++r)negm[r]=-mhat; asm volatile("":"+v"(negm)); } \
    _Pragma("unroll") for(int r=0;r<16;++r)P0[r]=__builtin_amdgcn_exp2f(P0[r]); }while(0)
  #define RESC() do{ if(resc){ asm volatile("s_waitcnt lgkmcnt(0)":::"memory"); \
      _Pragma("unroll") for(int d_=0;d_<2;++d_) _Pragma("unroll") for(int r=0;r<16;++r)o[d_][r]*=wsf[crow(r,hi)]; } }while(0)
  f32x16 pA0,pA1,pB0,pB1;
  int sl_prev=0,sl_cur=0,sl_next=SLOTB;
  #define ROT() do{sl_prev=sl_cur;sl_cur=sl_next;sl_next=(sl_next==(NSLOT-1)*SLOTB)?0:sl_next+SLOTB;}while(0)
  DMA_K(2,2*SLOTB);
  WAIT_BAR(3);
  qkt(pA0,pA1,Kbase,qr,negm,r32,hi);asm volatile("s_nop 15\n\ts_nop 7":"+v"(pA0),"+v"(pA1));CMASK(pA0,pA1,0);
  START(pA0,pA1);
  _Pragma("unroll") for(int r=0;r<16;++r)pA1[r]=__builtin_amdgcn_exp2f(pA1[r]);
  WAIT_BAR(0);
  DMA_K(3,0);DMA_V(1,SLOTB);
  ROT();
  kload8(kf,kp0+sl_cur);
  WAIT_BAR(2);
  s16x4 vlo[8],vhi[8]; u32x4 pw0,pw1,pw2,pw3;
  #define PKW(P,B) cvtpk_s(P[B],P[B+1])
  #define PAF(k) __builtin_bit_cast(bf16x8,pw##k)
  #define VFR(i) (bf16x8){vlo[i][0],vlo[i][1],vlo[i][2],vlo[i][3],vhi[i][0],vhi[i][1],vhi[i][2],vhi[i][3]}
  #define PIN(x) asm volatile("":"+v"(x))
  #define MX3(a,b,c) __builtin_fmaxf(__builtin_fmaxf((a),(b)),(c))
  #define GAPA(MF,A0,A1,A2,A3,W0,W1,PW) do{ MF; sacc+=A0; sacc+=A1; sacc+=A2; sacc+=A3; PIN(sacc); W0; W1; PIN(PW); SBAR(); }while(0)
  #define EX(v) __builtin_amdgcn_exp2f(v)
  #define GAPB(MF,X,B) do{ MF; X[B]=EX(X[B]); X[B+1]=EX(X[B+1]); X[B+2]=EX(X[B+2]); X[B+3]=EX(X[B+3]); PIN(X); SBAR(); }while(0)
  #define VRD(i) do{ vlo[i]=vtr(vp_+(((i)>>2)*4096+((i)&3)*1024)); vhi[i]=vtr(vp_+(((i)>>2)*4096+((i)&3)*1024+512)); }while(0)
  #define KRD(G,j) do{ if(G){ kload2(kf,kp0+sl_next,j); SBAR(); } }while(0)
  #define STEP(C0,C1,P0,P1,t,GK,GV,GL) do{ SBAR(); \
    const lds_cptr vp_=vp0+sl_prev; \
    VRD(0); SBAR(); float sacc=(P0[0]+P0[1]); \
    GAPA(C0=__builtin_amdgcn_mfma_f32_32x32x16_bf16(kf[0],qr[0],negm,0,0,0), P0[2],P0[3],P0[4],P0[5],     pw0[0]=PKW(P0,0), pw0[1]=PKW(P0,2), pw0); \
    VRD(4); SBAR(); GAPA(C1=__builtin_amdgcn_mfma_f32_32x32x16_bf16(kf[1],qr[0],negm,0,0,0), P0[6],P0[7],P0[8],P0[9],     pw0[2]=PKW(P0,4), pw0[3]=PKW(P0,6), pw0); \
    VRD(1); SBAR(); GAPA(C0=__builtin_amdgcn_mfma_f32_32x32x16_bf16(kf[2],qr[1],C0,0,0,0),   P0[10],P0[11],P0[12],P0[13], pw1[0]=PKW(P0,8), pw1[1]=PKW(P0,10), pw1); \
    VRD(5); SBAR(); GAPA(C1=__builtin_amdgcn_mfma_f32_32x32x16_bf16(kf[3],qr[1],C1,0,0,0),   P0[14],P0[15],P1[0],P1[1],   pw1[2]=PKW(P0,12),pw1[3]=PKW(P0,14), pw1); \
    VRD(2); SBAR(); GAPA(C0=__builtin_amdgcn_mfma_f32_32x32x16_bf16(kf[4],qr[2],C0,0,0,0),   P1[2],P1[3],P1[4],P1[5],     pw2[0]=PKW(P1,0), pw2[1]=PKW(P1,2), pw2); \
    VRD(6); SBAR(); GAPA(C1=__builtin_amdgcn_mfma_f32_32x32x16_bf16(kf[5],qr[2],C1,0,0,0),   P1[6],P1[7],P1[8],P1[9],     pw2[2]=PKW(P1,4), pw2[3]=PKW(P1,6), pw2); \
    VRD(3); SBAR(); GAPA(C0=__builtin_amdgcn_mfma_f32_32x32x16_bf16(kf[6],qr[3],C0,0,0,0),   P1[10],P1[11],P1[12],P1[13], pw3[0]=PKW(P1,8), pw3[1]=PKW(P1,10), pw3); \
    VRD(7); SBAR(); GAPA(C1=__builtin_amdgcn_mfma_f32_32x32x16_bf16(kf[7],qr[3],C1,0,0,0),   P1[14],P1[15],0.f,0.f,       pw3[2]=PKW(P1,12),pw3[3]=PKW(P1,14), pw3); \
    l_reg+=sacc; \
    if(GK){DMA_K((t)+3,sl_cur);} if(GV){DMA_V((t)+1,sl_next);} \
    CMASK(C0,C1,t); \
    { float a=MX3(C0[0],C0[1],C1[0]),b=MX3(C0[2],C0[3],C1[1]); a=MX3(a,C1[2],C1[3]); \
      _Pragma("unroll") for(int r=4;r<16;r+=4){a=MX3(a,C0[r],C0[r+1]);b=MX3(b,C0[r+2],C0[r+3]);a=MX3(a,C1[r],C1[r+1]);b=MX3(b,C1[r+2],C1[r+3]);} \
      float rm=__builtin_fmaxf(a,b); { auto rr=__builtin_amdgcn_permlane32_swap(__float_as_uint(rm),__float_as_uint(rm),false,false); rm=__builtin_fmaxf(__uint_as_float(rr[0]),__uint_as_float(rr[1])); } \
      resc=false; \
      if(__builtin_expect(__any(rm>(float)THRL),0)){ const float dl=__builtin_fmaxf(rm,0.f); mhat+=dl; \
        _Pragma("unroll") for(int r=0;r<16;++r){C0[r]-=dl;C1[r]-=dl;} \
        _Pragma("unroll") for(int r=0;r<16;++r)negm[r]=-mhat; asm volatile("":"+v"(negm)); \
        const float f=__builtin_amdgcn_exp2f(-dl); l_reg*=f; if(hi==0)wsf[r32]=f; resc=true; } } \
    SBAR(); \
    GAPB(o[0]=__builtin_amdgcn_mfma_f32_32x32x16_bf16(PAF(0),VFR(0),o[0],0,0,0), C0,0); \
    GAPB(o[1]=__builtin_amdgcn_mfma_f32_32x32x16_bf16(PAF(0),VFR(4),o[1],0,0,0), C0,4); \
    KRD(GL,0); GAPB(o[0]=__builtin_amdgcn_mfma_f32_32x32x16_bf16(PAF(1),VFR(1),o[0],0,0,0), C0,8); \
    KRD(GL,1); GAPB(o[1]=__builtin_amdgcn_mfma_f32_32x32x16_bf16(PAF(1),VFR(5),o[1],0,0,0), C0,12); \
    KRD(GL,2); GAPB(o[0]=__builtin_amdgcn_mfma_f32_32x32x16_bf16(PAF(2),VFR(2),o[0],0,0,0), C1,0); \
    KRD(GL,3); GAPB(o[1]=__builtin_amdgcn_mfma_f32_32x32x16_bf16(PAF(2),VFR(6),o[1],0,0,0), C1,4); \
    GAPB(o[0]=__builtin_amdgcn_mfma_f32_32x32x16_bf16(PAF(3),VFR(3),o[0],0,0,0), C1,8); \
    GAPB(o[1]=__builtin_amdgcn_mfma_f32_32x32x16_bf16(PAF(3),VFR(7),o[1],0,0,0), C1,12); \
    }while(0)
  int t=1;
  #undef CMASK
  #define CMASK(P0,P1,t) do{}while(0)
  for(;t+5<NT;t+=2){
    STEP(pB0,pB1,pA0,pA1,t,true,true,true);     WAIT_BAR(2); RESC(); ROT();
    STEP(pA0,pA1,pB0,pB1,t+1,true,true,true);   WAIT_BAR(2); RESC(); ROT();
  }
  #undef CMASK
  #define CMASK(P0,P1,t) do{}while(0)
  #define ENDW(tt) do{ if((tt)+3<NT){WAIT_BAR(2);} else if((tt)+2<NT){WAIT_BAR(1);} else {WAIT_BAR(0);} }while(0)
  for(;t+1<NT;t+=2){
    STEP(pB0,pB1,pA0,pA1,t,(t+3<NT),(t+1<NT),(t+1<NT));       ENDW(t);   RESC(); ROT();
    STEP(pA0,pA1,pB0,pB1,t+1,(t+4<NT),(t+2<NT),(t+2<NT));     ENDW(t+1); RESC(); ROT();
  }
  STEP(pB0,pB1,pA0,pA1,NT-1,false,false,false); RESC();
  { float sacc=pB0[0]+pB0[1]; _Pragma("unroll") for(int r=2;r<16;++r)sacc+=pB0[r]; _Pragma("unroll") for(int r=0;r<16;++r)sacc+=pB1[r]; l_reg+=sacc;
    pw0=(u32x4){PKW(pB0,0),PKW(pB0,2),PKW(pB0,4),PKW(pB0,6)};pw1=(u32x4){PKW(pB0,8),PKW(pB0,10),PKW(pB0,12),PKW(pB0,14)};pw2=(u32x4){PKW(pB1,0),PKW(pB1,2),PKW(pB1,4),PKW(pB1,6)};pw3=(u32x4){PKW(pB1,8),PKW(pB1,10),PKW(pB1,12),PKW(pB1,14)};
    SBAR(); pv(o,vb0+sl_cur,PAF(0),PAF(1),PAF(2),PAF(3)); }
  #undef PKW
  #undef PAF
  #undef VFR
  #undef PIN
  #undef MX3
  #undef GAPA
  #undef GAPB
  #undef EX
  #undef VRD
  #undef KRD
  #undef STEP
  #undef ENDW
  {auto rr=__builtin_amdgcn_permlane32_swap(__float_as_uint(l_reg),__float_as_uint(l_reg),false,false);l_reg=__uint_as_float(rr[0])+__uint_as_float(rr[1]);}
  if(hi==0)wsf[32+r32]=l_reg;asm volatile("s_waitcnt lgkmcnt(0)":::"memory");
  float rli[16];
  #pragma unroll
  for(int r=0;r<16;++r)rli[r]=__builtin_amdgcn_rcpf(wsf[32+crow(r,hi)]);
  bf16*Ow=O+(qrow0+wid*QBLK)*OP+h*D;
  { bf16*stg=(bf16*)(shm+LDS_OST)+wid*2048;
    #pragma unroll
    for(int r=0;r<16;++r){const int orow=crow(r,hi);
      #pragma unroll
      for(int d0=0;d0<2;++d0)stg[orow*64+d0*32+r32]=__float2bfloat16(o[d0][r]*rli[r]);}
    asm volatile("s_waitcnt lgkmcnt(0)":::"memory");
    #pragma unroll
    for(int i=0;i<4;++i){const int row=i*8+(lane>>3),ch=lane&7; const u32x4 v=*(const u32x4*)(stg+row*64+ch*8); ATTN_STORE16(Ow+(long)row*OP+ch*8,v);} }
  asm volatile("s_waitcnt lgkmcnt(0)\n\ts_barrier":::"memory");
  #undef DMA_K
  #undef DMA_V
  #undef CMASK
  #undef START
  #undef RESC
  #undef ROT
}
constexpr int ATTN_LDS_BYTES=LDS_BYTES;
#undef SBAR
#undef WAIT_BAR
}

#define REP_HY 1
#define REP_GQA 1
#define REP_NA 1
#define REP_NORM 1
#define REP_POST 1
#define REP_SYNC 1
#define REP_UP 1
#define REP_SK 1
#define REP_OUT 1
#define REP_GC 1
#define REP_F 1
#define REP_A 1
#define REP_IN 1
#define REP_W 1
#define REP_DOWN 1
#define REP_HYC 1
#define GRID_SYNC() do { for (int rs_ = 0; rs_ < REP_SYNC; ++rs_) xcd_barrier(xbar); } while (0)
#define LAS __attribute__((address_space(3)))
constexpr int LDS_BYTES = 131072 + 1024;
constexpr int NTHREADS = 512, NWAVES = 8;

__device__ __forceinline__ void p0_transpose_item(const float* __restrict__ W, int K, int N, bf16_t* __restrict__ WT, int mode, float* scr, int item, int lane) {
    const int nblk = N / 32, kb = item / nblk, nb = item % nblk, k0 = 64 * kb, n0 = 32 * nb;
    float tv[32];
#pragma unroll
    for (int i = 0; i < 32; ++i) tv[i] = W[(size_t)(k0 + 2 * i + (lane >> 5)) * N + n0 + (lane & 31)];
#pragma unroll
    for (int i = 0; i < 32; ++i) scr[(2 * i + (lane >> 5)) * 33 + (lane & 31)] = tv[i];
    asm volatile("s_waitcnt lgkmcnt(0)" ::: "memory");
    const int c = lane & 7;
#pragma unroll
    for (int j = 0; j < 4; ++j) { const int nl = (lane >> 3) + 8 * j; const float* s = scr + (8 * c) * 33 + nl;
        u32x4 o; o.x = pk2(s[0 * 33], s[1 * 33]); o.y = pk2(s[2 * 33], s[3 * 33]); o.z = pk2(s[4 * 33], s[5 * 33]); o.w = pk2(s[6 * 33], s[7 * 33]);
        const int n = n0 + nl;
        const int r = mode == 0 ? n : ((n >> 7) * 256 + (n & 127) + (mode == 2 ? 128 : 0));
        *(u32x4*)(WT + (size_t)r * K + k0 + 8 * c) = o; }
    asm volatile("s_waitcnt lgkmcnt(0)" ::: "memory");
}

struct MegaArgs { const float* in[31]; float* out; unsigned char* ws; };

__device__ __forceinline__ void p0_weights(const MegaArgs& a, unsigned char* lds, int it_lo, int it_hi, int wave, int lane) {
    float* scr = (float*)(lds + wave * 8448);
    constexpr int I_G = (D / 64) * (FF / 32), I_D = (FF / 64) * (D / 32), I_IN = (D / 64) * (INW / 32), I_OUT = (D / 64) * (D / 32);
    constexpr int I_LAYER = 4 * I_G + 2 * I_D + I_IN + I_OUT;
    unsigned char* ws = a.ws;
    for (int it = it_lo; it < it_hi; ++it) {
        const int l = it / I_LAYER; int r = it % I_LAYER;
        bool done = false;
#pragma unroll
        for (int f = 0; f < 2; ++f) {
            if (done) break;
            bf16_t* gu = (bf16_t*)(ws + WS_WGU) + (size_t)(l * 2 + f) * 2 * FF * D; bf16_t* dn = (bf16_t*)(ws + WS_WD) + (size_t)(l * 2 + f) * D * FF;
            const float* wg = (f == 0 ? a.in[7] : a.in[28]) + (size_t)l * D * FF; const float* wu = (f == 0 ? a.in[8] : a.in[29]) + (size_t)l * D * FF; const float* wd = (f == 0 ? a.in[9] : a.in[30]) + (size_t)l * FF * D;
            if (r < I_G) { p0_transpose_item(wg, D, FF, gu, 1, scr, r, lane); done = true; break; } r -= I_G;
            if (r < I_G) { p0_transpose_item(wu, D, FF, gu, 2, scr, r, lane); done = true; break; } r -= I_G;
            if (r < I_D) { p0_transpose_item(wd, FF, D, dn, 0, scr, r, lane); done = true; break; } r -= I_D;
        }
        if (done) continue;
        if (r < I_IN) { p0_transpose_item(a.in[11] + (size_t)l * D * INW, D, INW, (bf16_t*)(ws + WS_WIN) + (size_t)l * INW * D, 0, scr, r, lane); continue; } r -= I_IN;
        p0_transpose_item(a.in[12] + (size_t)l * D * D, D, D, (bf16_t*)(ws + WS_WOUT) + (size_t)l * D * D, 0, scr, r, lane);
    }
}

__device__ __forceinline__ void p0_adaln(const MegaArgs& a, const float* sc  , int it_lo, int it_hi, int lane) {
    const float* w = a.in[4]; const float* b = a.in[5]; float* mod = (float*)(a.ws + WS_MOD);
    constexpr int NCG = NMOD * D / 256;
    for (int it = it_lo; it < it_hi; ++it) {
        const int ks = it & 15, cgi = (it >> 4) % NCG, l = (it >> 4) / NCG;
        const int j = cgi * 256 + 4 * lane;
        const float* wl = w + (size_t)l * D * (NMOD * D) + (size_t)(ks * 64) * (NMOD * D) + j;
        f32x4 s0 = (f32x4){0.f, 0.f, 0.f, 0.f}, s1 = s0, s2 = s0;
#pragma unroll 16
        for (int k = 0; k < 64; ++k) { const f32x4 wv = *(const f32x4*)(wl + (size_t)k * (NMOD * D)); const int kk = ks * 64 + k; s0 += wv * sc[kk]; s1 += wv * sc[D + kk]; s2 += wv * sc[2 * D + kk]; }
        if (ks == 0) { const f32x4 bv = *(const f32x4*)(b + (size_t)l * NMOD * D + j); s0 += bv; s1 += bv; s2 += bv; }
        float* m = mod + (size_t)l * 3 * NMOD * D + j;
#pragma unroll
        for (int e = 0; e < 4; ++e) { atomicAdd(m + e, s0[e] * (1.0f / REP_A)); atomicAdd(m + NMOD * D + e, s1[e] * (1.0f / REP_A)); atomicAdd(m + 2 * NMOD * D + e, s2[e] * (1.0f / REP_A)); }
    }
}

#define FLT_LOAD(r, base, stride, nrows) do { _Pragma("unroll") for (int q_ = 0; q_ < 4; ++q_) { const int row_ = (lane >> 2) + 16 * q_; r[q_] = row_ < (nrows) ? *(const f32x4*)((base) + (size_t)row_ * (stride) + 4 * (lane & 3)) : (f32x4){0.f, 0.f, 0.f, 0.f}; } } while (0)
#define FLT_STORE(r) do { _Pragma("unroll") for (int q_ = 0; q_ < 4; ++q_) *(f32x4*)(wb + ((lane >> 2) + 16 * q_) * 16 + 4 * (lane & 3)) = r[q_]; } while (0)
#define FLT_FMA16(f, k) do { const f32x4 w0_ = *(const f32x4*)(wb + (k) * 16), w1_ = *(const f32x4*)(wb + (k) * 16 + 4), w2_ = *(const f32x4*)(wb + (k) * 16 + 8), w3_ = *(const f32x4*)(wb + (k) * 16 + 12); \
    _Pragma("unroll") for (int j_ = 0; j_ < 4; ++j_) { acc[j_] += (f) * w0_[j_]; acc[4 + j_] += (f) * w1_[j_]; acc[8 + j_] += (f) * w2_[j_]; acc[12 + j_] += (f) * w3_[j_]; } } while (0)
__device__ __forceinline__ void p0_filter_item(const MegaArgs& a, float* sm  , float* wb  , int pitem, bool active, int t256) {
    float (*feats)[33] = (float (*)[33])sm;
    float (*h1)[65] = (float (*)[65])(sm + 64 * 33);
    float (*h2)[65] = (float (*)[65])(sm + 64 * 33 + 64 * 65);
    const int l = active ? pitem / 132 : 0;
    int pb = active ? pitem % 132 : 0;
    const bool isctx = pb >= SEQ / 64;
    const int n = isctx ? CTX : SEQ;
    if (isctx) pb -= SEQ / 64;
    const int lane = t256 & 63, w = __builtin_amdgcn_readfirstlane(t256 >> 6);
    const int p = pb * 64 + lane;
    const float t = (float)p / (float)(n - 1);
    if (w == 0) {
        feats[lane][0] = t;
        for (int i = 0; i < 16; ++i) {
            const float band = 1e-4f + (float)i * ((15.0f - 1e-4f) / 15.0f);
            float rev = (float)p * band / (float)n; rev = rev - floorf(rev);
            feats[lane][1 + i] = __builtin_amdgcn_cosf(rev); feats[lane][17 + i] = -__builtin_amdgcn_sinf(rev);
        }
    }
    __syncthreads();
    const float* W1 = a.in[17] + (size_t)l * 33 * 64; const float* B1 = a.in[18] + l * 64; const float* W2 = a.in[19] + (size_t)l * 64 * 64; const float* B2 = a.in[20] + l * 64;
    const float* W3 = a.in[21] + (size_t)l * 64 * 512; const float* FR = a.in[22] + l * 64;
    float* KF = (float*)(a.ws + WS_KF); float* KFC = (float*)(a.ws + WS_KFC); float* fnorm = (float*)(a.ws + WS_FNORM);
    {
        float acc[16];
#pragma unroll
        for (int j = 0; j < 16; ++j) acc[j] = B1[16 * w + j];
        { f32x4 r[4]; FLT_LOAD(r, W1 + 16 * w, 64, 33); FLT_STORE(r); }
#pragma unroll 3
        for (int k = 0; k < 33; ++k) { const float f = feats[lane][k]; FLT_FMA16(f, k); }
#pragma unroll
        for (int j = 0; j < 16; ++j) h1[lane][16 * w + j] = fast_sin(FR[16 * w + j] * acc[j]);
    }
    __syncthreads();
    {
        float acc[16];
#pragma unroll
        for (int j = 0; j < 16; ++j) acc[j] = B2[16 * w + j];
        { f32x4 r[4]; FLT_LOAD(r, W2 + 16 * w, 64, 64); FLT_STORE(r); }
#pragma unroll 4
        for (int k = 0; k < 64; ++k) { const float f = h1[lane][k]; FLT_FMA16(f, k); }
#pragma unroll
        for (int j = 0; j < 16; ++j) h2[lane][16 * w + j] = fast_sin(FR[16 * w + j] * acc[j]);
    }
    __syncthreads();
    const float dlo = logf(1e-2f) / 1.5f, dhi = logf(1e-2f) / 0.3f;
    if (active) {
        const int r32 = lane & 31, hi = lane >> 5;
        f32x16 acc[2][4];
#pragma unroll
        for (int pt = 0; pt < 2; ++pt)
#pragma unroll
            for (int ct = 0; ct < 4; ++ct) acc[pt][ct] = (f32x16){};
        const float* wcol = W3 + 128 * w + r32 + hi * 512;
#pragma unroll 4
        for (int ks = 0; ks < 32; ++ks) {
            const float a0 = h2[r32][2 * ks + hi], a1 = h2[32 + r32][2 * ks + hi];
            float bw[4];
#pragma unroll
            for (int ct = 0; ct < 4; ++ct) bw[ct] = wcol[(size_t)(2 * ks) * 512 + 32 * ct];
#pragma unroll
            for (int ct = 0; ct < 4; ++ct) { acc[0][ct] = __builtin_amdgcn_mfma_f32_32x32x2f32(a0, bw[ct], acc[0][ct], 0, 0, 0); acc[1][ct] = __builtin_amdgcn_mfma_f32_32x32x2f32(a1, bw[ct], acc[1][ct], 0, 0, 0); }
        }
        float* T = sm + w * 1568;
        const float tinv = 1.0f / (float)(n - 1);
#pragma unroll
        for (int ct = 0; ct < 4; ++ct) {
            const int col = 128 * w + 32 * ct + r32, dir = col >> 8, c = col & 255;
            const float adel = fabsf(dlo + (dhi - dlo) * ((float)c / 255.0f));
            float asum = 0.f;
#pragma unroll
            for (int pt = 0; pt < 2; ++pt) {
#pragma unroll
                for (int r = 0; r < 16; ++r) {
                    const int pl = (r & 3) + 8 * (r >> 2) + 4 * hi, pp = pb * 64 + 32 * pt + pl;
                    float v = acc[pt][ct][r] * __expf(-(float)pp * tinv * adel);
                    if (dir == 1 && pp == 0) v = 0.f;
                    asum += fabsf(v);
                    T[r32 * 33 + pl] = v;
                }
#pragma unroll 4
                for (int i = 0; i < 16; ++i) {
                    const int cc = 2 * i + hi, ocol = 128 * w + 32 * ct + cc, odir = ocol >> 8, oc = ocol & 255;
                    const float v = T[cc * 33 + r32];
                    const int pp = pb * 64 + 32 * pt + r32, lag = odir == 0 ? pp : -pp;
                    if (!(odir == 1 && pp == 0)) {
                        if (isctx) KFC[((size_t)l * 256 + oc) * 512 + lag + CTX] = v; else KF[((size_t)l * 256 + oc) * 16384 + lag + SEQ] = v;
                    }
                }
            }
            asum += __shfl_xor(asum, 32);
            if (hi == 0) atomicAdd(&fnorm[(l * 2 + (isctx ? 1 : 0)) * 256 + c], asum * (1.0f / REP_F));
        }
    }
    __syncthreads();
}

__device__ __forceinline__ void norm_load(const float* __restrict__ hlat, float* __restrict__ hctx, const float* __restrict__ part, int nparts, int row, int lane, f32x4 (&v)[4]) {
    const float* src = row < MLAT ? hlat + (size_t)row * D : hctx + (size_t)(row - MLAT) * D;
#pragma unroll
    for (int j = 0; j < 4; ++j) v[j] = *(const f32x4*)(src + 256 * j + 4 * lane);
    if (row >= MLAT && nparts > 0) {
        for (int p = 0; p < nparts; ++p) { const float* pp = part + ((size_t)p * MCTX + (row - MLAT)) * D + 4 * lane;
#pragma unroll
            for (int j = 0; j < 4; ++j) v[j] += *(const f32x4*)(pp + 256 * j); }
#pragma unroll
        for (int j = 0; j < 4; ++j) *(f32x4*)(hctx + (size_t)(row - MLAT) * D + 256 * j + 4 * lane) = v[j];
    }
}
__device__ __forceinline__ void norm_finish(const float* __restrict__ g, const float* __restrict__ mod, int shift_idx, bf16_t* __restrict__ XN, int row, int lane, const f32x4 (&v)[4]) {
    const float* m = mod + (size_t)mod_of_row(row) * NMOD * D;
    const float* sh = m + shift_idx * D; const float* sc = m + (shift_idx + 1) * D;
    float ss = 0.f;
#pragma unroll
    for (int j = 0; j < 4; ++j) ss += v[j].x * v[j].x + v[j].y * v[j].y + v[j].z * v[j].z + v[j].w * v[j].w;
    const float rstd = 1.0f / sqrtf(wave_sum(ss) * (1.f / D) + EPS);
#pragma unroll
    for (int j = 0; j < 4; ++j) {
        const int c0 = 256 * j + 4 * lane;
        const f32x4 gv = *(const f32x4*)(g + c0), sv = *(const f32x4*)(sc + c0), hv = *(const f32x4*)(sh + c0);
        const float aa = v[j].x * rstd * gv.x * (1.f + sv.x) + hv.x, bb = v[j].y * rstd * gv.y * (1.f + sv.y) + hv.y;
        const float cc = v[j].z * rstd * gv.z * (1.f + sv.z) + hv.z, dd = v[j].w * rstd * gv.w * (1.f + sv.w) + hv.w;
        u32x2 o; o.x = pk2(aa, bb); o.y = pk2(cc, dd);
        *(u32x2*)(XN + (size_t)row * D + c0) = o;
    }
}
__device__ __forceinline__ void norm_rows(const float* __restrict__ hlat, float* __restrict__ hctx, const float* __restrict__ part, int nparts, const float* __restrict__ g, const float* __restrict__ mod, int shift_idx, bf16_t* __restrict__ XN, int M, int gw, int ngw, int lane) {
    for (int row = gw; row < M; row += 2 * ngw) {
        f32x4 va[4], vb[4];
        const int rowb = row + ngw; const bool hb = rowb < M;
        norm_load(hlat, hctx, part, nparts, row, lane, va);
        if (hb) norm_load(hlat, hctx, part, nparts, rowb, lane, vb);
        norm_finish(g, mod, shift_idx, XN, row, lane, va);
        if (hb) norm_finish(g, mod, shift_idx, XN, rowb, lane, vb);
    }
}


struct Post2Args { const bf16_t* PX; const float *gqa, *gka, *gqn, *gkn, *convw, *convb, *rope; bf16_t *QA, *KA, *VAT, *NQ, *NK, *NVT, *ZT, *X0T; };
__device__ __forceinline__ void unpack8(const u32x4 p, float (&v)[8]) {
    v[0] = __builtin_bit_cast(float, p.x << 16); v[1] = __builtin_bit_cast(float, p.x & 0xffff0000u); v[2] = __builtin_bit_cast(float, p.y << 16); v[3] = __builtin_bit_cast(float, p.y & 0xffff0000u);
    v[4] = __builtin_bit_cast(float, p.z << 16); v[5] = __builtin_bit_cast(float, p.z & 0xffff0000u); v[6] = __builtin_bit_cast(float, p.w << 16); v[7] = __builtin_bit_cast(float, p.w & 0xffff0000u);
}
__device__ __forceinline__ u32x4 pack8(const float (&v)[8]) { u32x4 o; o.x = pk2(v[0], v[1]); o.y = pk2(v[2], v[3]); o.z = pk2(v[4], v[5]); o.w = pk2(v[6], v[7]); return o; }
__device__ __forceinline__ void headnorm8(float (&v)[8], const float (&g)[8]) {
    float ss = 0.f;
#pragma unroll
    for (int e = 0; e < 8; ++e) ss += v[e] * v[e];
    ss += __shfl_xor(ss, 1); ss += __shfl_xor(ss, 2); ss += __shfl_xor(ss, 4);
    const float rstd = 1.0f / sqrtf(ss * (1.f / 64.f) + EPS);
#pragma unroll
    for (int e = 0; e < 8; ++e) v[e] = v[e] * rstd * g[e];
}
__device__ __forceinline__ void post_unit(const Post2Args& a, int row0, int T, LAS unsigned char* lds3) {
    int tid = threadIdx.x; asm volatile("" : "+v"(tid));
    const int lane = tid & 63, w = __builtin_amdgcn_readfirstlane(tid >> 6), l7 = lane & 7;
    const bool isctx = row0 >= MLAT;
    const int b = isctx ? (row0 - MLAT) / CTX : row0 / SEQ;
    const int tu0 = isctx ? (row0 - MLAT) % CTX : row0 % SEQ;
    const int n = isctx ? CTX : SEQ, kv0 = isctx ? tu0 : CTX + tu0, R = T >> 3;
    constexpr int TP = 516;
    float gq[8], gk[8], gnq[8], gnk[8];
#pragma unroll
    for (int e = 0; e < 8; ++e) { gq[e] = a.gqa[8 * l7 + e]; gk[e] = a.gka[8 * l7 + e]; gnq[e] = a.gqn[8 * l7 + e]; gnk[e] = a.gkn[8 * l7 + e]; }
    const int ch1 = lane >= 32 ? 8 * lane - 256 : 0, ch2 = 256 + 8 * lane;
    float cw1[3][8], cb1[8], cw2[3][8], cb2[8];
#pragma unroll
    for (int e = 0; e < 8; ++e) { cb1[e] = a.convb[ch1 + e]; cb2[e] = a.convb[ch2 + e];
#pragma unroll
        for (int j = 0; j < 3; ++j) { cw1[j][e] = a.convw[j * 768 + ch1 + e]; cw2[j][e] = a.convw[j * 768 + ch2 + e]; } }
    const int pairb = (l7 >> 1) & 1, axis = l7 >> 2, f0 = 8 * (lane & 1);
    for (int i = 0; i < R; ++i) {
        const int tl = w * R + i, t = tu0 + tl, row = row0 + tl;
        const bf16_t* px = a.PX + (size_t)row * INW + 8 * lane;
        const u32x4 z4 = (u32x4){0u, 0u, 0u, 0u};
        const u32x4 p0 = *(const u32x4*)(px), p1 = *(const u32x4*)(px + 512), p2 = *(const u32x4*)(px + 1024), p3 = *(const u32x4*)(px + 1536);
        const u32x4 p4 = lane < 32 ? *(const u32x4*)(px + 2048) : z4;
        const u32x4 a1 = t > 0 ? *(const u32x4*)(px + 512 - INW) : z4, a2 = t > 0 ? *(const u32x4*)(px + 1024 - INW) : z4;
        const u32x4 n1 = t < n - 1 ? *(const u32x4*)(px + 512 + INW) : z4, n2 = t < n - 1 ? *(const u32x4*)(px + 1024 + INW) : z4;
        float cs[8], sn[8];
        { const int pos = axis == 0 ? (t / GRIDW) : (t % GRIDW); const float* rc = a.rope + pos * 16 + f0;
          const f32x4 c0 = *(const f32x4*)rc, c1 = *(const f32x4*)(rc + 4), s0 = *(const f32x4*)(rc + 2048), s1 = *(const f32x4*)(rc + 2052);
#pragma unroll
          for (int e = 0; e < 4; ++e) { cs[e] = c0[e]; cs[4 + e] = c1[e]; sn[e] = s0[e]; sn[4 + e] = s1[e]; } }
        float v[8];
        unpack8(p0, v); headnorm8(v, gq);
        if (!isctx) {
#pragma unroll
            for (int e = 0; e < 8; ++e) { const float o = __shfl_xor(v[e], 2); v[e] = pairb == 0 ? v[e] * cs[e] - o * sn[e] : o * sn[e] + v[e] * cs[e]; } }
#pragma unroll
        for (int e = 0; e < 8; ++e) v[e] *= (0.125f * LOG2E);
        *(u32x4*)(a.QA + (size_t)row * 512 + 8 * lane) = pack8(v);
        unpack8(p1, v); headnorm8(v, gk);
        if (!isctx) {
#pragma unroll
            for (int e = 0; e < 8; ++e) { const float o = __shfl_xor(v[e], 2); v[e] = pairb == 0 ? v[e] * cs[e] - o * sn[e] : o * sn[e] + v[e] * cs[e]; } }
        if (lane < 16) *(u32x4*)(a.KA + ((size_t)b * KVLEN + kv0 + tl) * 128 + 8 * lane) = pack8(v);
        else if (lane < 32) *(u32x4*)(a.VAT + ((size_t)b * KVLEN + kv0 + tl) * 128 + 8 * (lane - 16)) = p1;
        unpack8(p3, v);
        if (lane < 32) { headnorm8(v, gnq);
#pragma unroll
            for (int e = 0; e < 8; ++e) v[e] *= (0.125f * LOG2E);
            *(u32x4*)(a.NQ + (size_t)row * 256 + 8 * lane) = pack8(v); }
        else { headnorm8(v, gnk); *(u32x4*)(a.NK + ((size_t)b * KVLEN + kv0 + tl) * 256 + 8 * (lane - 32)) = pack8(v); }
        float x1v[8], x0v[8], pv[8], cv[8], nv_[8];
        unpack8(a1, pv); unpack8(p1, cv); unpack8(n1, nv_);
#pragma unroll
        for (int e = 0; e < 8; ++e) x0v[e] = cb1[e] + cw1[0][e] * pv[e] + cw1[1][e] * cv[e] + cw1[2][e] * nv_[e];
        unpack8(a2, pv); unpack8(p2, cv); unpack8(n2, nv_);
#pragma unroll
        for (int e = 0; e < 8; ++e) x1v[e] = cb2[e] + cw2[0][e] * pv[e] + cw2[1][e] * cv[e] + cw2[2][e] * nv_[e];
#pragma unroll
        for (int e = 0; e < 8; ++e) { const float o = __shfl_xor(x1v[e], 32); v[e] = lane < 32 ? x1v[e] * o : x0v[e]; }
        { LAS unsigned* dst = (LAS unsigned*)(lds3 + (lane < 32 ? 0 : 64 * TP) + tl * TP + 16 * (lane & 31));
          const u32x4 o = pack8(v); dst[0] = o.x; dst[1] = o.y; dst[2] = o.z; dst[3] = o.w; }
        if (lane < 32) { LAS unsigned* dst = (LAS unsigned*)(lds3 + 128 * TP + tl * TP + 16 * lane); dst[0] = p4.x; dst[1] = p4.y; dst[2] = p4.z; dst[3] = p4.w; }
    }
    __syncthreads();
    {
        const int lpc = T >> 1, cpi = 64 / lpc, cl = lane / lpc, tt = 2 * (lane % lpc);
#pragma unroll
        for (int k = 0; k < 3; ++k) {
            bf16_t* dstb = (k == 0 ? a.ZT : (k == 1 ? a.X0T : a.NVT)) + (size_t)b * 256 * KVLEN + kv0 + tt;
            const LAS unsigned char* tile = lds3 + k * 64 * TP + tt * TP;
            for (int c0 = w * 32; c0 < w * 32 + 32; c0 += cpi) { const int c = c0 + cl;
                const unsigned lo = *(const LAS unsigned short*)(tile + 2 * c), hi = *(const LAS unsigned short*)(tile + TP + 2 * c);
                *(unsigned*)(dstb + (size_t)c * KVLEN) = lo | (hi << 16); }
        }
    }
    __syncthreads();
}

constexpr int NA_RPB_OFF = 122880;
__device__ __forceinline__ void na_compute(const bf16x8 (&kf)[4], const bf16x8 (&vf)[4], const bf16x8 (&qf)[2], f32x4 (&o)[4], float& mrun, float& lrun, int g, bool win, int kc0, int cs, const LAS float* rprow) {
    f32x4 sA = (f32x4){0.f, 0.f, 0.f, 0.f}, sB = sA;
#pragma unroll
    for (int ks = 0; ks < 2; ++ks) {
        sA = __builtin_amdgcn_mfma_f32_16x16x32_bf16(kf[2 * ks], qf[ks], sA, 0, 0, 0);
        sB = __builtin_amdgcn_mfma_f32_16x16x32_bf16(kf[2 * ks + 1], qf[ks], sB, 0, 0, 0);
    }
    if (win) {
#pragma unroll
        for (int r = 0; r < 4; ++r) {
            const int kca = kc0 + 8 * g + r, kcb = kca + 4;
            sA[r] = (kca >= cs && kca < cs + 16) ? sA[r] + rprow[kca] : -INFINITY;
            sB[r] = (kcb >= cs && kcb < cs + 16) ? sB[r] + rprow[kcb] : -INFINITY;
        }
    }
    float mx = fmaxf(fmaxf(fmaxf(sA.x, sA.y), fmaxf(sA.z, sA.w)), fmaxf(fmaxf(sB.x, sB.y), fmaxf(sB.z, sB.w)));
    mx = fmaxf(mx, __shfl_xor(mx, 16)); mx = fmaxf(mx, __shfl_xor(mx, 32));
    const float mnew = fmaxf(mrun, mx), alpha = __builtin_amdgcn_exp2f(mrun - mnew);
    mrun = mnew;
    float p[8];
    p[0] = __builtin_amdgcn_exp2f(sA.x - mnew); p[1] = __builtin_amdgcn_exp2f(sA.y - mnew); p[2] = __builtin_amdgcn_exp2f(sA.z - mnew); p[3] = __builtin_amdgcn_exp2f(sA.w - mnew);
    p[4] = __builtin_amdgcn_exp2f(sB.x - mnew); p[5] = __builtin_amdgcn_exp2f(sB.y - mnew); p[6] = __builtin_amdgcn_exp2f(sB.z - mnew); p[7] = __builtin_amdgcn_exp2f(sB.w - mnew);
    lrun = lrun * alpha + ((p[0] + p[1]) + (p[2] + p[3])) + ((p[4] + p[5]) + (p[6] + p[7]));
    u32x4 pw; pw.x = pk2(p[0], p[1]); pw.y = pk2(p[2], p[3]); pw.z = pk2(p[4], p[5]); pw.w = pk2(p[6], p[7]);
    const bf16x8 pf = __builtin_bit_cast(bf16x8, pw);
#pragma unroll
    for (int dt = 0; dt < 4; ++dt) { o[dt] = o[dt] * alpha; o[dt] = __builtin_amdgcn_mfma_f32_16x16x32_bf16(vf[dt], pf, o[dt], 0, 0, 0); }
}
__device__ __forceinline__ void na_wave2(const bf16_t* __restrict__ NQ, const bf16_t* __restrict__ NK, const bf16_t* __restrict__ NVT, const LAS float* rp, bf16_t* __restrict__ Y, int row0, int h, int lane) {
    const int fr = lane & 15, g = lane >> 4;
    const bool isctx = row0 >= MLAT;
    const int b = isctx ? (row0 - MLAT) / CTX : row0 / SEQ;
    const int t0 = isctx ? (row0 - MLAT) % CTX : row0 % SEQ;
    const int r = t0 / GRIDW, q0 = t0 % GRIDW, qc = q0 + fr;
    const int rs = min(max(r - 4, 0), SEQ / GRIDW - 8), cs = min(max(qc - 8, 0), GRIDW - 16);
    bf16x8 qf[2];
#pragma unroll
    for (int ks = 0; ks < 2; ++ks) qf[ks] = *(const bf16x8*)(NQ + (size_t)(row0 + fr) * 256 + h * 64 + 32 * ks + 8 * g);
    const int keyA = 8 * (fr >> 2) + (fr & 3);
    const bf16_t* Kb = NK + (size_t)b * KVLEN * 256 + h * 64 + 8 * g + (size_t)keyA * 256;
    const bf16_t* Vb = NVT + ((size_t)b * 4 + h) * 64 * KVLEN + 8 * g + (size_t)fr * KVLEN;
    f32x4 o[4];
#pragma unroll
    for (int i = 0; i < 4; ++i) o[i] = (f32x4){0.f, 0.f, 0.f, 0.f};
    float mrun = -INFINITY, lrun = 0.f;
    const int kb_lo = q0 >= 48 ? 1 : 0, two = (q0 == 16 || q0 == 32) ? 1 : 0;
    const int nblk = isctx ? 8 : 8 + (8 << two);
#define NA_INFO(j, key0, kc0, roff) do { if ((j) < 8) { key0 = 32 * (j); kc0 = 0; roff = 0; } else { const int jj_ = (j) - 8, i_ = jj_ >> two, kb_ = kb_lo + (jj_ & two); \
        key0 = CTX + (rs + i_) * GRIDW + 32 * kb_; kc0 = 32 * kb_; roff = (h * 15 + (rs + i_ - r + 7)) * 31 + 15 - qc; } } while (0)
#define NA_LOAD(key0, kf, vf) do { const bf16_t* kp_ = Kb + (size_t)(key0) * 256; kf[0] = *(const bf16x8*)(kp_); kf[1] = *(const bf16x8*)(kp_ + 4 * 256); kf[2] = *(const bf16x8*)(kp_ + 32); kf[3] = *(const bf16x8*)(kp_ + 4 * 256 + 32); \
        _Pragma("unroll") for (int dt_ = 0; dt_ < 4; ++dt_) vf[dt_] = *(const bf16x8*)(Vb + (size_t)(16 * dt_) * KVLEN + (key0)); } while (0)
    bf16x8 kf0[4], vf0[4], kf1[4], vf1[4];
    int key0a, kc0a, roffa, key0b, kc0b, roffb;
    NA_INFO(0, key0a, kc0a, roffa); NA_LOAD(key0a, kf0, vf0);
    for (int j = 0; j < nblk; j += 2) {
        NA_INFO(j + 1, key0b, kc0b, roffb); NA_LOAD(key0b, kf1, vf1);
        na_compute(kf0, vf0, qf, o, mrun, lrun, g, j >= 8, kc0a, cs, rp + roffa);
        { const int jn = min(j + 2, nblk - 1); NA_INFO(jn, key0a, kc0a, roffa); NA_LOAD(key0a, kf0, vf0); }
        na_compute(kf1, vf1, qf, o, mrun, lrun, g, j + 1 >= 8, kc0b, cs, rp + roffb);
    }
#undef NA_INFO
#undef NA_LOAD
    lrun += __shfl_xor(lrun, 16); lrun += __shfl_xor(lrun, 32);
    const float il = 1.0f / lrun;
#pragma unroll
    for (int dt = 0; dt < 4; ++dt) { u32x2 ov; ov.x = pk2(o[dt].x * il, o[dt].y * il); ov.y = pk2(o[dt].z * il, o[dt].w * il);
        *(u32x2*)(Y + (size_t)(row0 + fr) * D + 768 + h * 64 + 16 * dt + 4 * g) = ov; }
}


__device__ __forceinline__ void na_pair(const bf16_t* __restrict__ NQ, const bf16_t* __restrict__ NK, const bf16_t* __restrict__ NVT, const LAS float* rp, bf16_t* __restrict__ Y, int b, int h, int p, int lane) {
    const int fr = lane & 15, g = lane >> 4;
    const bool isctx = p >= 256;
    const int r = isctx ? 0 : (p >> 1), type = isctx ? 1 : (p & 1);
    const int q0A = type ? 16 : 0, q0B = type ? 32 : 48;
    const int rowA = isctx ? MLAT + b * CTX + (p - 256) * 32 : b * SEQ + r * GRIDW + q0A;
    const int rowB = isctx ? rowA + 16 : b * SEQ + r * GRIDW + q0B;
    const int qcA = q0A + fr, qcB = q0B + fr;
    const int rs = min(max(r - 4, 0), SEQ / GRIDW - 8), csA = min(max(qcA - 8, 0), GRIDW - 16), csB = min(max(qcB - 8, 0), GRIDW - 16);
    bf16x8 qfA[2], qfB[2];
#pragma unroll
    for (int ks = 0; ks < 2; ++ks) { qfA[ks] = *(const bf16x8*)(NQ + (size_t)(rowA + fr) * 256 + h * 64 + 32 * ks + 8 * g); qfB[ks] = *(const bf16x8*)(NQ + (size_t)(rowB + fr) * 256 + h * 64 + 32 * ks + 8 * g); }
    const int keyA = 8 * (fr >> 2) + (fr & 3);
    const bf16_t* Kb = NK + (size_t)b * KVLEN * 256 + h * 64 + 8 * g + (size_t)keyA * 256;
    const bf16_t* Vb = NVT + ((size_t)b * 4 + h) * 64 * KVLEN + 8 * g + (size_t)fr * KVLEN;
    f32x4 oA[4], oB[4];
#pragma unroll
    for (int i = 0; i < 4; ++i) { oA[i] = (f32x4){0.f, 0.f, 0.f, 0.f}; oB[i] = oA[i]; }
    float mA = -INFINITY, lA = 0.f, mB = -INFINITY, lB = 0.f;
    const int nit = isctx ? 4 : 12;
#define NP_KEY(it, y) ((it) < 4 ? 64 * (it) + 32 * (y) : CTX + (rs + (it) - 4) * GRIDW + 32 * (y))
#define NA_LOAD(key0, kf, vf) do { const bf16_t* kp_ = Kb + (size_t)(key0) * 256; kf[0] = *(const bf16x8*)(kp_); kf[1] = *(const bf16x8*)(kp_ + 4 * 256); kf[2] = *(const bf16x8*)(kp_ + 32); kf[3] = *(const bf16x8*)(kp_ + 4 * 256 + 32); \
        _Pragma("unroll") for (int dt_ = 0; dt_ < 4; ++dt_) vf[dt_] = *(const bf16x8*)(Vb + (size_t)(16 * dt_) * KVLEN + (key0)); } while (0)
    bf16x8 kf0[4], vf0[4], kf1[4], vf1[4];
    NA_LOAD(NP_KEY(0, 0), kf0, vf0);
    for (int it = 0; it < nit; ++it) {
        NA_LOAD(NP_KEY(it, 1), kf1, vf1);
        const bool win = it >= 4, both = !win || type != 0;
        const int rrow = (h * 15 + (rs + it - 4 - r + 7)) * 31 + 15;
        const LAS float* rpA = rp + (win ? rrow - qcA : 0); const LAS float* rpB = rp + (win ? rrow - qcB : 0);
        na_compute(kf0, vf0, qfA, oA, mA, lA, g, win, 0, csA, rpA);
        if (both) na_compute(kf0, vf0, qfB, oB, mB, lB, g, win, 0, csB, rpB);
        { const int itn = min(it + 1, nit - 1); NA_LOAD(NP_KEY(itn, 0), kf0, vf0); }
        if (both) na_compute(kf1, vf1, qfA, oA, mA, lA, g, win, 32, csA, rpA);
        na_compute(kf1, vf1, qfB, oB, mB, lB, g, win, 32, csB, rpB);
    }
#undef NP_KEY
#undef NA_LOAD
    lA += __shfl_xor(lA, 16); lA += __shfl_xor(lA, 32); lB += __shfl_xor(lB, 16); lB += __shfl_xor(lB, 32);
    const float ilA = 1.0f / lA, ilB = 1.0f / lB;
#pragma unroll
    for (int dt = 0; dt < 4; ++dt) { u32x2 ov; ov.x = pk2(oA[dt].x * ilA, oA[dt].y * ilA); ov.y = pk2(oA[dt].z * ilA, oA[dt].w * ilA);
        *(u32x2*)(Y + (size_t)(rowA + fr) * D + 768 + h * 64 + 16 * dt + 4 * g) = ov;
        ov.x = pk2(oB[dt].x * ilB, oB[dt].y * ilB); ov.y = pk2(oB[dt].z * ilB, oB[dt].w * ilB);
        *(u32x2*)(Y + (size_t)(rowB + fr) * D + 768 + h * 64 + 16 * dt + 4 * g) = ov; }
}

constexpr int HY_POFF = 8208, HY_PSZ = 16416, HY_ZBLK = 72, HY_ZLEN = 160 * HY_ZBLK;
constexpr int HY_LDS = HY_PSZ * 4 + 2 * HY_ZLEN * 2;
__device__ __forceinline__ int crow32(int r, int hi) { return (r & 3) + 8 * (r >> 2) + 4 * hi; }
__device__ __forceinline__ void hyena_mfma_unit(const bf16_t* __restrict__ ZT  , const float* __restrict__ kf  , float inorm, float sk,
                                                const bf16_t* __restrict__ X0T, bf16_t* __restrict__ Y, int c, LAS unsigned char* lds3) {
    int tid = threadIdx.x; asm volatile("" : "+v"(tid));
    const int lane = tid & 63, w = __builtin_amdgcn_readfirstlane(tid >> 6), r32 = lane & 31, hi = lane >> 5;
    LAS unsigned* P = (LAS unsigned*)lds3; LAS bf16_t* ZP = (LAS bf16_t*)(lds3 + HY_PSZ * 4);
    for (int g8 = tid; g8 < HY_PSZ / 8; g8 += NTHREADS) {
        const int w0 = 8 * g8 - HY_POFF;
        float tv[9];
#pragma unroll
        for (int j = 0; j < 9; ++j) { const int ww = w0 - 1 + j; tv[j] = (ww >= -(SEQ - 1) && ww <= SEQ - 1) ? kf[ww + SEQ] : 0.f; }
        u32x4 lo, hi4;
        hi4.w = pk2(tv[1], tv[0]); hi4.z = pk2(tv[2], tv[1]); hi4.y = pk2(tv[3], tv[2]); hi4.x = pk2(tv[4], tv[3]);
        lo.w = pk2(tv[5], tv[4]); lo.z = pk2(tv[6], tv[5]); lo.y = pk2(tv[7], tv[6]); lo.x = pk2(tv[8], tv[7]);
        *(LAS u32x4*)(P + HY_PSZ - 8 - 8 * g8) = lo; *(LAS u32x4*)(P + HY_PSZ - 4 - 8 * g8) = hi4;
    }
    { static_assert((2 * (SEQ / 8)) % NTHREADS == 0, "z fill");
      u32x4 zt[2 * (SEQ / 8) / NTHREADS];
#pragma unroll
      for (int j = 0; j < 2 * (SEQ / 8) / NTHREADS; ++j) { const int idx = tid + j * NTHREADS, bb = idx / (SEQ / 8), e8 = (idx % (SEQ / 8)) * 8; zt[j] = *(const u32x4*)(ZT + ((size_t)bb * 256 + c) * KVLEN + CTX + e8); }
#pragma unroll
      for (int j = 0; j < 2 * (SEQ / 8) / NTHREADS; ++j) { const int idx = tid + j * NTHREADS, bb = idx / (SEQ / 8), e8 = (idx % (SEQ / 8)) * 8; *(LAS u32x4*)(ZP + bb * HY_ZLEN + (16 + (e8 >> 6)) * HY_ZBLK + (e8 & 63)) = zt[j]; } }
    for (int idx = tid; idx < 4 * 16 * 8; idx += NTHREADS) { const int q = idx >> 7, blk = (idx >> 3) & 15, e8 = (idx & 7) * 8;
        *(LAS u32x4*)(ZP + (q >> 1) * HY_ZLEN + (((q & 1) ? 144 : 0) + blk) * HY_ZBLK + e8) = (u32x4){0u, 0u, 0u, 0u}; }
    __syncthreads();
    f32x16 acc0 = {}, acc1 = {};
    const int b = r32 >> 4, tb = 16 * w + (r32 & 15);
    const LAS bf16_t* zlane = ZP + b * HY_ZLEN + (16 + tb) * HY_ZBLK + 8 * hi;
    const LAS unsigned* plane = P + (HY_PSZ - 1 - HY_POFF) - r32 + 8 * hi;
    const int dlo = 16 * w - 127, dhi = 16 * w + 15;
#define HY_AFR(A, e, d) do { const LAS unsigned* pp_ = plane - 64 * (d) - 16 * ((e) - 3); A[e].x = pp_[0]; A[e].y = pp_[2]; A[e].z = pp_[4]; A[e].w = pp_[6]; } while (0)
#define HY_LOAD(A, B, d) do { _Pragma("unroll") for (int ks_ = 0; ks_ < 4; ++ks_) B[ks_] = *(const LAS bf16x8*)(zlane - HY_ZBLK * (d) + 16 * ks_); HY_AFR(A, 2, d); HY_AFR(A, 3, d); HY_AFR(A, 4, d); HY_AFR(A, 5, d); } while (0)
#define HY_MMA(A, B) do { _Pragma("unroll") for (int ks_ = 0; ks_ < 4; ++ks_) { \
        acc0 = __builtin_amdgcn_mfma_f32_32x32x16_bf16(__builtin_bit_cast(bf16x8, A[3 - ks_]), B[ks_], acc0, 0, 0, 0); \
        acc1 = __builtin_amdgcn_mfma_f32_32x32x16_bf16(__builtin_bit_cast(bf16x8, A[5 - ks_]), B[ks_], acc1, 0, 0, 0); } } while (0)
    u32x4 AX[6], AY[6]; bf16x8 BX[4], BY[4];
    HY_AFR(AX, 0, dlo); HY_AFR(AX, 1, dlo); HY_LOAD(AX, BX, dlo);
    for (int d = dlo; d + 1 <= dhi; d += 2) {
        AY[0] = AX[4]; AY[1] = AX[5]; HY_LOAD(AY, BY, d + 1);
        HY_MMA(AX, BX);
        AX[0] = AY[4]; AX[1] = AY[5]; HY_LOAD(AX, BX, d + 2);
        HY_MMA(AY, BY);
    }
    HY_MMA(AX, BX);
#undef HY_AFR
#undef HY_LOAD
#undef HY_MMA
    __syncthreads();
    LAS bf16_t* XL = (LAS bf16_t*)lds3;
    { u32x4 xt[2 * (SEQ / 8) / NTHREADS];
#pragma unroll
      for (int j = 0; j < 2 * (SEQ / 8) / NTHREADS; ++j) { const int idx = tid + j * NTHREADS, bb = idx / (SEQ / 8), e8 = (idx % (SEQ / 8)) * 8; xt[j] = *(const u32x4*)(X0T + ((size_t)bb * 256 + c) * KVLEN + CTX + e8); }
#pragma unroll
      for (int j = 0; j < 2 * (SEQ / 8) / NTHREADS; ++j) { const int idx = tid + j * NTHREADS, bb = idx / (SEQ / 8), e8 = (idx % (SEQ / 8)) * 8; *(LAS u32x4*)(XL + bb * SEQ + e8) = xt[j]; } }
    __syncthreads();
#pragma unroll
    for (int i0 = 0; i0 < 2; ++i0)
#pragma unroll
        for (int r = 0; r < 16; ++r) {
            const int t = 64 * tb + 32 * i0 + crow32(r, hi); const size_t row = (size_t)b * SEQ + t;
            const float zv = bf2f(ZP[b * HY_ZLEN + (16 + (t >> 6)) * HY_ZBLK + (t & 63)]);
            const float y = (i0 == 0 ? acc0[r] : acc1[r]) * inorm + zv * sk;
            Y[row * D + 512 + c] = (bf16_t)f2bf(y * bf2f(XL[b * SEQ + t]));
        }
    __syncthreads();
}

__device__ __forceinline__ void hyena_ctx_item(const bf16_t* __restrict__ ZT, const float* __restrict__ KFC, const float* __restrict__ fnorm, const float* __restrict__ skip, const bf16_t* __restrict__ X0T, bf16_t* __restrict__ Y, int item, int t) {
    const int c = item & 255, b = item >> 8;
    const bf16_t* zp = ZT + ((size_t)b * 256 + c) * KVLEN; const float* kf = KFC + (size_t)c * 512;
    float acc = 0.f;
    for (int s = 0; s < CTX; ++s) acc += kf[t - s + CTX] * bf2f(zp[s]);
    const size_t row = (size_t)MLAT + b * CTX + t;
    const float y = acc / fnorm[c] + bf2f(zp[t]) * skip[c];
    Y[row * D + 512 + c] = (bf16_t)f2bf(y * bf2f(X0T[((size_t)b * 256 + c) * KVLEN + t]));
}

#define XB_TMO      128
#define XB_XCNT(j)  (256  + 64 * (j))
#define XB_XSUB(j)  (1280 + 64 * (j))
#define XB_XGEN(j)  (2304 + 64 * (j))
#define XB_TOP      3328
#define XB_TOPGEN   3392
#define XCD_BAR_WORDS 3456
#define XB_SPIN_CAP (1u << 18)

__device__ __forceinline__ unsigned xb_ld(unsigned* p)              { return __hip_atomic_load(p, __ATOMIC_RELAXED, __HIP_MEMORY_SCOPE_AGENT); }
__device__ __forceinline__ unsigned xb_add(unsigned* p, unsigned v) { return __hip_atomic_fetch_add(p, v, __ATOMIC_RELAXED, __HIP_MEMORY_SCOPE_AGENT); }
__device__ __forceinline__ unsigned xb_xcc_id() { return (unsigned)__builtin_amdgcn_s_getreg((3 << 11) | 20) & 0xFu; }
#define XB_SPIN(cond, bar) do { unsigned _sp = 0; while (cond) { __builtin_amdgcn_s_sleep(1); \
    if ((++_sp & 255u) == 0u) { if (xb_ld(&(bar)[XB_TMO])) break; if (_sp > XB_SPIN_CAP) { atomicAdd(&(bar)[XB_TMO], 1u); break; } } } } while (0)

struct XcdBarrier {
    unsigned* bar; unsigned x;
    volatile LAS unsigned* st;
};

__device__ __forceinline__ XcdBarrier xcd_barrier_post(unsigned* bar, volatile LAS unsigned* st) {
    XcdBarrier b; b.bar = bar; b.x = xb_xcc_id(); b.st = st;
    if (threadIdx.x == 0) (void)xb_add(&bar[XB_XCNT(b.x)], 1u);
    return b;
}
__device__ __forceinline__ void xcd_barrier_complete(unsigned* bar, unsigned x, unsigned& nloc, unsigned& nx) {
    const unsigned G = gridDim.x * gridDim.y * gridDim.z;
    unsigned sum, cnt, mine, sp = 0u;
    for (;;) {
        sum = 0u; cnt = 0u; mine = 0u;
#pragma unroll
        for (unsigned j = 0; j < 16; ++j) { const unsigned c = xb_ld(&bar[XB_XCNT(j)]); sum += c; cnt += (c > 0u) ? 1u : 0u; mine = (j == x) ? c : mine; }
        if (sum == G) break;
        __builtin_amdgcn_s_sleep(1);
        if ((++sp & 255u) == 0u) { if (xb_ld(&bar[XB_TMO])) break; if (sp > XB_SPIN_CAP) { atomicAdd(&bar[XB_TMO], 1u); break; } }
    }
    nloc = mine > 0u ? mine : 1u; nx = cnt > 0u ? cnt : 1u;
}

__device__ __forceinline__ void xcd_barrier(const XcdBarrier& b) {
    asm volatile("s_waitcnt vmcnt(0)" ::: "memory");
    __syncthreads();
    if (threadIdx.x == 0) {
        unsigned* bar = b.bar;
        __builtin_amdgcn_s_waitcnt(0);
        unsigned nloc = b.st[0], nx = b.st[1];
        if (nloc == 0u) { xcd_barrier_complete(bar, b.x, nloc, nx); b.st[0] = nloc; b.st[1] = nx; }
        const unsigned old = xb_add(&bar[XB_XSUB(b.x)], 1u);
        const unsigned gen = old / nloc;
        if (old + 1u == (gen + 1u) * nloc) {
            __builtin_amdgcn_fence(__ATOMIC_RELEASE, "agent");
            asm volatile("s_waitcnt vmcnt(0)" ::: "memory");
            const unsigned og = xb_add(&bar[XB_TOP], 1u);
            const unsigned tg = og / nx;
            if (og + 1u == (tg + 1u) * nx) xb_add(&bar[XB_TOPGEN], 1u);
            else XB_SPIN(xb_ld(&bar[XB_TOPGEN]) == tg, bar);
            __builtin_amdgcn_fence(__ATOMIC_ACQUIRE, "agent");
            xb_add(&bar[XB_XGEN(b.x)], 1u);
            asm volatile("s_waitcnt vmcnt(0)" ::: "memory");
        } else {
            XB_SPIN(xb_ld(&bar[XB_XGEN(b.x)]) == gen, bar);
            __builtin_amdgcn_fence(__ATOMIC_ACQUIRE, "agent");
            asm volatile("s_waitcnt vmcnt(0)" ::: "memory");
        }
    }
    __syncthreads();
}

__global__ void __launch_bounds__(NTHREADS, 2) mega_fwd(MegaArgs a) {
    extern __shared__ __attribute__((aligned(16))) unsigned char lds[];
    cg::grid_group grid = cg::this_grid();
    const int tid0 = threadIdx.x, wave = __builtin_amdgcn_readfirstlane(tid0 >> 6), half = __builtin_amdgcn_readfirstlane(tid0 >> 8);
#define PHASE_TID() int tid = threadIdx.x; asm volatile("" : "+v"(tid)); const int lane = tid & 63, t256 = tid & 255; (void)lane; (void)t256
    const int G = gridDim.x, bx = blockIdx.x;
    const int gw = bx * NWAVES + wave, ngw = G * NWAVES;
    const int vb = bx * 2 + half, nvb = G * 2;
    unsigned char* ws = a.ws;
    float* hlat = a.out; float* hctx = (float*)(ws + WS_HCTX);
    float* mod = (float*)(ws + WS_MOD); float* fnorm = (float*)(ws + WS_FNORM);
    bf16_t* XN = (bf16_t*)(ws + WS_XN); bf16_t* HID = (bf16_t*)(ws + WS_HID); bf16_t* PX = (bf16_t*)(ws + WS_PX);
    bf16_t* QA = (bf16_t*)(ws + WS_QA); bf16_t* KA = (bf16_t*)(ws + WS_KA); bf16_t* VAT = (bf16_t*)(ws + WS_VAT);
    bf16_t* NQ = (bf16_t*)(ws + WS_NQ); bf16_t* NK = (bf16_t*)(ws + WS_NK); bf16_t* NV = (bf16_t*)(ws + WS_NV);
    bf16_t* ZT = (bf16_t*)(ws + WS_Z); float* ROPE = (float*)(ws + WS_ZC); bf16_t* X0T = (bf16_t*)(ws + WS_X0);
    bf16_t* YMIX = (bf16_t*)(ws + WS_YMIX); float* KF = (float*)(ws + WS_KF); float* KFC = (float*)(ws + WS_KFC); float* PART = (float*)(ws + WS_PART);
    LAS unsigned char* lds3 = (LAS unsigned char*)lds;
    volatile LAS unsigned* bst = (volatile LAS unsigned*)(lds3 + 131072);
    for (size_t i = (size_t)bx * NTHREADS + threadIdx.x; i < (1 * MiB) / 16; i += (size_t)G * NTHREADS) ((u32x4*)(ws + WS_CTL))[i] = (u32x4){0u, 0u, 0u, 0u};
    if (threadIdx.x < 2) bst[threadIdx.x] = 0u;
    grid.sync();
    const XcdBarrier xbar = xcd_barrier_post((unsigned*)(ws + WS_BAR), bst);

    {
        PHASE_TID();
        for (int rp_ = 0; rp_ < REP_F; ++rp_) for (int it0 = bx * 2; it0 < DEPTH * 132; it0 += nvb) { const int it = it0 + half; p0_filter_item(a, (float*)(lds + half * 41728), (float*)(lds + 83456 + wave * 4096), it, it < DEPTH * 132, t256); }
        __syncthreads();
        float* sc = (float*)(lds + 69632);
        const float* c = a.in[1]; const float* cctx = a.in[3];
        for (int i = tid; i < D; i += NTHREADS) { sc[i] = silu_f(c[i]); sc[D + i] = silu_f(c[D + i]); sc[2 * D + i] = silu_f(cctx[i]); }
        __syncthreads();
        for (int i = bx * NTHREADS + tid; i < 128 * 16; i += G * NTHREADS) { const int pos = i >> 4, f = i & 15;
            const float inv = exp2f(-(float)f * (13.287712379549449f / 16.0f)); float rev = (float)pos * inv * 0.15915494309189535f; rev = rev - floorf(rev);
            ROPE[i] = __builtin_amdgcn_cosf(rev); ROPE[2048 + i] = __builtin_amdgcn_sinf(rev); }
        const f32x4* xs = (const f32x4*)a.in[0]; f32x4* xd = (f32x4*)hlat;
        for (size_t i = (size_t)bx * NTHREADS + tid; i < (size_t)MLAT * D / 4; i += (size_t)G * NTHREADS) xd[i] = xs[i];
        const f32x4* cs = (const f32x4*)a.in[2]; f32x4* cd = (f32x4*)hctx;
        for (size_t i = (size_t)bx * NTHREADS + tid; i < (size_t)MCTX * D / 4; i += (size_t)G * NTHREADS) cd[i] = cs[i];
        {
            constexpr int NA_ITEMS = DEPTH * (NMOD * D / 256) * 16;
            constexpr int NW_ITEMS = DEPTH * (4 * ((D / 64) * (FF / 32)) + 2 * ((FF / 64) * (D / 32)) + (D / 64) * (INW / 32) + (D / 64) * (D / 32));
            unsigned* qctr = (unsigned*)(ws + WS_QCTR);
            for (;;) {
                unsigned qb = 0; if (lane == 0) qb = atomicAdd(qctr, 4u);
                const int base = (int)__builtin_amdgcn_readfirstlane(qb);
                if (base >= NA_ITEMS + NW_ITEMS) break;
                const int hi = min(base + 4, NA_ITEMS + NW_ITEMS);
                if (base < NA_ITEMS) p0_adaln(a, sc, base, min(hi, NA_ITEMS), lane);
                if (hi > NA_ITEMS) p0_weights(a, lds, max(base, NA_ITEMS) - NA_ITEMS, hi - NA_ITEMS, wave, lane);
            }
        }
    }
    GRID_SYNC();

    for (int l = 0; l < DEPTH; ++l) {
        const float* modl = mod + (size_t)l * 3 * NMOD * D;
        const bool last = (l == DEPTH - 1);
        for (int f = 0; f < 2; ++f) {
            if (f == 1) {
                { PHASE_TID(); for (int rp_ = 0; rp_ < REP_NORM; ++rp_) norm_rows(hlat, hctx, PART, 11, a.in[10] + l * D, modl, 3, XN, MTOT, gw, ngw, lane); }
                GRID_SYNC();
                { pg8::Gemm g{XN, (const bf16_t*)(ws + WS_WIN) + (size_t)l * INW * D, MTOT, INW, D, D}; pg8::StaticOrder S; S.init(MTOT, INW, G, bx);
                  pg8::EpiBf16 E{PX, INW};
                  for (int rp_ = 0; rp_ < REP_IN; ++rp_) pg8::gemm_phase<pg8::EpiBf16, pg8::StaticOrder, true, true>(lds3, g, S, E); }
                GRID_SYNC();
                { Post2Args pa; pa.PX = PX; pa.gqa = a.in[13] + l * 64; pa.gka = a.in[14] + l * 64; pa.gqn = a.in[24] + l * 64; pa.gkn = a.in[25] + l * 64; pa.convw = a.in[15] + (size_t)l * 3 * 768; pa.convb = a.in[16] + l * 768; pa.rope = ROPE;
                  pa.QA = QA; pa.KA = KA; pa.VAT = VAT; pa.NQ = NQ; pa.NK = NK; pa.NVT = NV; pa.ZT = ZT; pa.X0T = X0T;
                  for (int rp_ = 0; rp_ < REP_POST; ++rp_)
                  for (int u = bx; u < MLAT / 64; u += G) post_unit(pa, u * 64, 64, lds3);
                  for (int u = bx; u < MCTX / 16; u += G) post_unit(pa, MLAT + u * 16, 16, lds3); }
                GRID_SYNC();
                {
                    PHASE_TID();
                    const float* rpbl = a.in[26] + (size_t)l * 4 * 15 * 31;
                    LAS float* rp = (LAS float*)(lds3 + NA_RPB_OFF);
                    for (int i = tid; i < 4 * 15 * 31; i += NTHREADS) rp[i] = rpbl[i] * LOG2E;
                    __syncthreads();
                    for (int rp_ = 0; rp_ < REP_HY; ++rp_)
                    for (int c = bx; c < 256; c += G) { const float* fnl = fnorm + (l * 2 + 0) * 256;
                        hyena_mfma_unit(ZT, KF + ((size_t)l * 256 + c) * 16384, 1.0f / fnl[c], a.in[23][l * 256 + c], X0T, YMIX, c, lds3); }
                    {
                        const int grp = (bx & 7) >> 1, jl = (bx >> 3) * 2 + (bx & 1);
                        const int gb = grp >> 1, gk = grp & 1;
                        if (G == 256) {
                        for (int i = 0; i < 2 * REP_GQA; ++i) { const int u = jl + 64 * (i & 1), hh = u >> 5, qb = u & 31;
                            attn_body::attn_unit<8>((long)gb * SEQ + qb * 256, gk * 4 + hh, (long)gb * KVLEN, KVLEN, (const attn_body::bf16*)QA, (const attn_body::bf16*)KA, (const attn_body::bf16*)VAT, (attn_body::bf16*)YMIX, (char*)lds); }
                        } else {
                        for (int u = bx; u < 512; u += G) { const int ub = u >> 8, uh = (u >> 5) & 7, qb = u & 31;
                            attn_body::attn_unit<8>((long)ub * SEQ + qb * 256, uh, (long)ub * KVLEN, KVLEN, (const attn_body::bf16*)QA, (const attn_body::bf16*)KA, (const attn_body::bf16*)VAT, (attn_body::bf16*)YMIX, (char*)lds); }
                        }
                        if (!last) for (int cu = bx; cu < 16; cu += G) attn_body::attn_unit<8>((long)MLAT + (cu >> 3) * CTX, cu & 7, (long)(cu >> 3) * KVLEN, CTX, (const attn_body::bf16*)QA, (const attn_body::bf16*)KA, (const attn_body::bf16*)VAT, (attn_body::bf16*)YMIX, (char*)lds);
                        __syncthreads();
                    }
                    const int n_na = (last ? MLAT : MTOT) / 16 * 4;
                    for (int rp_ = 0; rp_ < REP_NA; ++rp_) {
                    if (G == 256) {
                        const int xb = (bx & 7) >> 2, xh = bx & 3, lw = (bx >> 3) * NWAVES + wave, nqi = SEQ / 16 + (last ? 0 : CTX / 16);
                        (void)nqi; for (int p = lw; p < 256 + (last ? 0 : 8); p += 256) na_pair(NQ, NK, NV, rp, YMIX, xb, xh, p, lane);
                    } else {
                        (void)n_na; const int npp = 256 + (last ? 0 : 8); for (int it = gw; it < 8 * npp; it += ngw) na_pair(NQ, NK, NV, rp, YMIX, (it / npp) >> 2, (it / npp) & 3, it % npp, lane);
                    } }
                    if (!last) for (int rp_ = 0; rp_ < REP_HYC; ++rp_) for (int it = vb; it < 512; it += nvb) hyena_ctx_item(ZT, KFC + (size_t)l * 256 * 512, fnorm + (l * 2 + 1) * 256, a.in[23] + l * 256, X0T, YMIX, it, t256);
                }
                GRID_SYNC();
                { pg8::Gemm g{YMIX, (const bf16_t*)(ws + WS_WOUT) + (size_t)l * D * D, MLAT, D, D, D}; pg8::StaticOrder S; S.init(MLAT, D, G, bx);
                  pg8::EpiRes E{hlat, hctx, modl, 5, 1.0f / REP_OUT};
                  for (int rp_ = 0; rp_ < REP_OUT; ++rp_) pg8::gemm_phase<pg8::EpiRes, pg8::StaticOrder, true, true>(lds3, g, S, E);
                  if (!last) { pg8::Gemm g2{YMIX, (const bf16_t*)(ws + WS_WOUT) + (size_t)l * D * D, MTOT, D, 256, D}; pg8::SplitKOrder S2{8 * 4, G, (bx + 64) % G, 4, 4, 64};
                    pg8::EpiResPart E2{PART, modl, 5, 1.0f};
                    for (int rp_ = 0; rp_ < REP_SK; ++rp_) pg8::gemm_phase<pg8::EpiResPart, pg8::SplitKOrder, false, true>(lds3, g2, S2, E2); } }
                GRID_SYNC();
            }
            const int Mf = (last && f == 1) ? MLAT : MTOT;
            { PHASE_TID(); for (int rp_ = 0; rp_ < REP_NORM; ++rp_) norm_rows(hlat, hctx, PART, f == 0 ? (l > 0 ? 11 : 0) : 4, (f == 0 ? a.in[6] : a.in[27]) + l * D, modl, f == 0 ? 0 : 6, XN, Mf, gw, ngw, lane); }
            GRID_SYNC();
            { pg8::Gemm g{XN, (const bf16_t*)(ws + WS_WGU) + (size_t)(l * 2 + f) * 2 * FF * D, Mf, 2 * FF, D, D}; pg8::StaticOrder S; S.init(Mf, 2 * FF, G, bx);
              pg8::EpiSwiGLU E{HID, FF};
              for (int rp_ = 0; rp_ < REP_UP; ++rp_) pg8::gemm_phase<pg8::EpiSwiGLU, pg8::StaticOrder, true, true>(lds3, g, S, E); }
            GRID_SYNC();
            { pg8::Gemm g{HID, (const bf16_t*)(ws + WS_WD) + (size_t)(l * 2 + f) * D * FF, MLAT, D, FF, FF}; pg8::StaticOrder S; S.init(MLAT, D, G, bx);
              pg8::EpiRes E{hlat, hctx, modl, f == 0 ? 2 : 8, 0.5f / REP_DOWN};
              for (int rp_ = 0; rp_ < REP_DOWN; ++rp_) pg8::gemm_phase<pg8::EpiRes, pg8::StaticOrder, true, true>(lds3, g, S, E);
              if (Mf == MTOT) { pg8::Gemm g2{HID, (const bf16_t*)(ws + WS_WD) + (size_t)(l * 2 + f) * D * FF, MTOT, D, 256, FF}; pg8::SplitKOrder S2{8 * 11, G, (bx + 64) % G, 11, 4, 64};
                pg8::EpiResPart E2{PART, modl, f == 0 ? 2 : 8, 0.5f};
                for (int rp_ = 0; rp_ < REP_SK; ++rp_) pg8::gemm_phase<pg8::EpiResPart, pg8::SplitKOrder, false, true>(lds3, g2, S2, E2); } }
            GRID_SYNC();
        }
    }
}

extern "C" void kernel_launch(void* const* d_in, const int* in_sizes, int n_in, void* d_out, int out_size, void* d_ws, size_t ws_size, hipStream_t stream) {
    static int grid = 0;
    if (grid == 0) {
        if (n_in != 31 || ws_size < WS_END) { fprintf(stderr, "kernel_launch: unexpected n_in %d or ws_size %zu < %zu\n", n_in, ws_size, (size_t)WS_END); grid = -1; return; }
        int dev = 0, cus = 0, per_cu = 0;
        (void)hipGetDevice(&dev); (void)hipDeviceGetAttribute(&cus, hipDeviceAttributeMultiprocessorCount, dev);
        if (hipFuncSetAttribute((const void*)mega_fwd, hipFuncAttributeMaxDynamicSharedMemorySize, LDS_BYTES) != hipSuccess) { fprintf(stderr, "kernel_launch: hipFuncSetAttribute failed\n"); grid = -1; return; }
        if (hipOccupancyMaxActiveBlocksPerMultiprocessor(&per_cu, (const void*)mega_fwd, NTHREADS, LDS_BYTES) != hipSuccess || per_cu < 1) { fprintf(stderr, "kernel_launch: occupancy query says %d\n", per_cu); per_cu = 1; }
        (void)hipGetLastError();
        grid = cus;
        fprintf(stderr, "kernel_launch: cus %d per_cu %d grid %d\n", cus, per_cu, grid);
    }
    if (grid < 0) return;
    MegaArgs a{};
    for (int i = 0; i < 31; ++i) a.in[i] = (const float*)d_in[i];
    a.out = (float*)d_out; a.ws = (unsigned char*)d_ws;
    void* args[] = {&a};
    hipError_t e = hipLaunchCooperativeKernel((const void*)mega_fwd, dim3(grid), dim3(NTHREADS), args, LDS_BYTES, stream);
    if (e != hipSuccess) fprintf(stderr, "kernel_launch: cooperative launch failed: %s (grid %d)\n", hipGetErrorString(e), grid);
}
```

```cpp
#include <hip/hip_runtime.h>
#include <cstdint>
#include <cstdio>
#include <hip/hip_cooperative_groups.h>
namespace cg = cooperative_groups;

typedef unsigned short bf16_t;
typedef short bf16x8 __attribute__((ext_vector_type(8)));
typedef float f32x4 __attribute__((ext_vector_type(4)));
typedef float f32x16 __attribute__((ext_vector_type(16)));
typedef unsigned u32x2 __attribute__((ext_vector_type(2)));
typedef unsigned u32x4 __attribute__((ext_vector_type(4)));

constexpr int D = 1024, BATCH = 2, SEQ = 8192, DEPTH = 4, CTX = 256, HD = 64;
constexpr int MLAT = BATCH * SEQ, MCTX = BATCH * CTX, MTOT = MLAT + MCTX;
constexpr int FF = 2816, INW = 2304, NMOD = 9, GRIDW = 64;
constexpr int KVLEN = CTX + SEQ;
constexpr float EPS = 1e-6f;
constexpr float LOG2E = 1.4426950408889634f;

constexpr size_t MiB = 1u << 20;
constexpr size_t al(size_t x) { return (x + 255) & ~(size_t)255; }
constexpr size_t WS_CTL = 0;
constexpr size_t WS_BAR = 16384;
constexpr size_t WS_QCTR = 32768;
constexpr size_t WS_FNORM = 4096;
constexpr size_t WS_MOD = 65536;
constexpr size_t WS_WGU = 2 * MiB;
constexpr size_t WS_WD = WS_WGU + al((size_t)DEPTH * 2 * 2 * FF * D * 2);
constexpr size_t WS_WIN = WS_WD + al((size_t)DEPTH * 2 * D * FF * 2);
constexpr size_t WS_WOUT = WS_WIN + al((size_t)DEPTH * INW * D * 2);
constexpr size_t WS_HCTX = WS_WOUT + al((size_t)DEPTH * D * D * 2);
constexpr size_t WS_XN = WS_HCTX + al((size_t)MCTX * D * 4);
constexpr size_t WS_HID = WS_XN + al((size_t)MTOT * D * 2);
constexpr size_t WS_PX = WS_HID;
constexpr size_t WS_QA = WS_HID + al((size_t)MTOT * FF * 2);
constexpr size_t WS_KA = WS_QA + al((size_t)MTOT * 512 * 2);
constexpr size_t WS_VAT = WS_KA + al((size_t)BATCH * KVLEN * 128 * 2);
constexpr size_t WS_NQ = WS_VAT + al((size_t)BATCH * KVLEN * 128 * 2);
constexpr size_t WS_NK = WS_NQ + al((size_t)MTOT * 256 * 2);
constexpr size_t WS_NV = WS_NK + al((size_t)BATCH * KVLEN * 256 * 2);
constexpr size_t WS_Z = WS_NV + al((size_t)BATCH * KVLEN * 256 * 2);
constexpr size_t WS_ZC = WS_Z + al((size_t)BATCH * 256 * SEQ * 4);
constexpr size_t WS_X0 = WS_ZC + al((size_t)BATCH * 256 * CTX * 4);
constexpr size_t WS_YMIX = WS_X0 + al((size_t)MTOT * 256 * 4);
constexpr size_t WS_KF = WS_YMIX + al((size_t)MTOT * D * 2);
constexpr size_t WS_KFC = WS_KF + al((size_t)DEPTH * 256 * 16384 * 4);
constexpr size_t WS_PART = WS_KFC + al((size_t)DEPTH * 256 * 512 * 4);
constexpr size_t WS_END = WS_PART + al((size_t)11 * MCTX * D * 4);

__device__ __forceinline__ unsigned f2bf(float f) { unsigned u = __builtin_bit_cast(unsigned, f); return (u + 0x7fffu + ((u >> 16) & 1u)) >> 16; }
__device__ __forceinline__ float bf2f(bf16_t b) { return __builtin_bit_cast(float, (unsigned)b << 16); }
typedef float f32x2_pk __attribute__((ext_vector_type(2))); typedef __bf16 bf16x2_pk __attribute__((ext_vector_type(2)));
__device__ __forceinline__ unsigned pk2(float lo, float hi) { f32x2_pk v = {lo, hi}; bf16x2_pk b = __builtin_convertvector(v, bf16x2_pk); return __builtin_bit_cast(unsigned, b); }
__device__ __forceinline__ float wave_sum(float v) {
#pragma unroll
    for (int o = 1; o < 64; o <<= 1) v += __shfl_xor(v, o);
    return v;
}
__device__ __forceinline__ float wave_max(float v) {
#pragma unroll
    for (int o = 1; o < 64; o <<= 1) v = fmaxf(v, __shfl_xor(v, o));
    return v;
}
__device__ __forceinline__ float fast_sin(float x) { float r = x * 0.15915494309189535f; r = r - floorf(r); return __builtin_amdgcn_sinf(r); }
__device__ __forceinline__ float silu_f(float x) { return x / (1.f + __expf(-x)); }
__device__ __forceinline__ int mod_of_row(int row) { return row < SEQ ? 0 : (row < MLAT ? 1 : 2); }

namespace pg8 {
#define PG8_LAS __attribute__((address_space(3)))
typedef unsigned short bf16_t;
typedef short bf16x8 __attribute__((ext_vector_type(8)));
typedef float f32x4 __attribute__((ext_vector_type(4)));
typedef unsigned u32x4 __attribute__((ext_vector_type(4)));
constexpr int BM = 256, BK = 64, HALF = 128, HTB = HALF * BK * 2  , STAGE_BYTES = 8 * HTB, NXCD = 8, WGM = 8;

__host__ __device__ __forceinline__ int lds_byte(int r, int c) { const int st = (r >> 4) * 2 + (c >> 5), rr = r & 15, cc = c & 31, ob = rr * 64 + cc * 2; return st * 1024 + (ob ^ (((ob >> 9) & 1) << 5)); }
__host__ __device__ __forceinline__ void stage_rc(int b, int& R, int& C) { const int st = b / 1024, sb = b % 1024, swz = sb ^ (((sb >> 9) & 1) << 5); R = (st >> 1) * 16 + swz / 64; C = (st & 1) * 32 + (swz % 64) / 2; }
__host__ __device__ __forceinline__ int perm32(int rho) { const int n = rho >> 4, i = rho & 15; return 8 * (i >> 2) + 4 * n + (i & 3); }

struct Unit { int pm, pn, ks; };
struct Gemm { const bf16_t* A; const bf16_t* Bt; int M, N, K, ld; };

struct StaticOrder {
    int nM, nN, nwg, G, c;
    __host__ __device__ void init(int M, int N, int G_, int c_) { nM = M / BM; nN = N / BM; nwg = nM * nN; G = G_; c = c_; }
    __host__ __device__ bool next(int i, Unit& u) const {
        const long L = (long)i * G + c; if (L >= nwg) return false;
        int wgid = (int)L; { const int q = nwg / NXCD, r = nwg % NXCD, xcd = wgid % NXCD, off = wgid / NXCD; wgid = (xcd < r ? xcd * (q + 1) : r * (q + 1) + (xcd - r) * q) + off; }
        const int nig = WGM * nN, gid = wgid / nig, fm = gid * WGM, gsz = (nM - fm) < WGM ? (nM - fm) : WGM;
        u.pm = fm + ((wgid % nig) % gsz); u.pn = (wgid % nig) / gsz; u.ks = 0; return true;
    }
    __device__ __forceinline__ void a_ready(const Unit&) const {}
    __device__ __forceinline__ void done(const Unit&) const {}
};

__device__ __forceinline__ unsigned cvt_pk_bf16(float lo, float hi) { unsigned r; asm volatile("v_cvt_pk_bf16_f32 %0, %1, %2" : "=v"(r) : "v"(lo), "v"(hi)); return r; }
struct EpiBf16 {
    static constexpr bool PERM = true, AFTER_DRAIN = false;
    bf16_t* O; int ldc;
    __device__ __forceinline__ void operator()(const f32x4 (&acc)[2][2][4][2], const Unit& u, int wr, int wc, int fr, int fq) const {
        const int row0 = u.pm * BM + wr * 64 + fr; const int col0 = u.pn * BM + wc * 32 + 8 * fq;
#pragma unroll
        for (int ai = 0; ai < 2; ++ai)
#pragma unroll
            for (int m = 0; m < 4; ++m) { bf16_t* rowp = O + (size_t)(row0 + ai * HALF + m * 16) * ldc + col0;
#pragma unroll
                for (int bj = 0; bj < 2; ++bj) { const f32x4 v0 = acc[ai][bj][m][0], v1 = acc[ai][bj][m][1];
                    u32x4 w; w.x = cvt_pk_bf16(v0[0], v0[1]); w.y = cvt_pk_bf16(v0[2], v0[3]); w.z = cvt_pk_bf16(v1[0], v1[1]); w.w = cvt_pk_bf16(v1[2], v1[3]);
                    *(u32x4*)(rowp + bj * HALF) = w; } }
    }
};
__device__ __forceinline__ float silu_e(float x) { return x * __builtin_amdgcn_rcpf(1.f + __builtin_amdgcn_exp2f(-1.4426950408889634f * x)); }
struct EpiSwiGLU {
    static constexpr bool PERM = true, AFTER_DRAIN = false;
    bf16_t* O; int ldc;
    __device__ __forceinline__ void operator()(const f32x4 (&acc)[2][2][4][2], const Unit& u, int wr, int wc, int fr, int fq) const {
        const int row0 = u.pm * BM + wr * 64 + fr; const int col0 = u.pn * HALF + wc * 32 + 8 * fq;
#pragma unroll
        for (int ai = 0; ai < 2; ++ai)
#pragma unroll
            for (int m = 0; m < 4; ++m) { bf16_t* rowp = O + (size_t)(row0 + ai * HALF + m * 16) * ldc + col0;
                const f32x4 g0 = acc[ai][0][m][0], g1 = acc[ai][0][m][1], u0 = acc[ai][1][m][0], u1 = acc[ai][1][m][1];
                u32x4 w; w.x = cvt_pk_bf16(silu_e(g0[0]) * u0[0], silu_e(g0[1]) * u0[1]); w.y = cvt_pk_bf16(silu_e(g0[2]) * u0[2], silu_e(g0[3]) * u0[3]);
                w.z = cvt_pk_bf16(silu_e(g1[0]) * u1[0], silu_e(g1[1]) * u1[1]); w.w = cvt_pk_bf16(silu_e(g1[2]) * u1[2], silu_e(g1[3]) * u1[3]);
                *(u32x4*)rowp = w; }
    }
};
struct SplitKOrder {
    int nunits, G, c, nks, nN, pm0;
    __host__ __device__ bool next(int i, Unit& u) const { const int L = i * G + c; if (L >= nunits) return false; u.ks = L % nks; const int tile = L / nks; u.pm = pm0 + tile / nN; u.pn = tile % nN; return true; }
    __device__ __forceinline__ void a_ready(const Unit&) const {}
    __device__ __forceinline__ void done(const Unit&) const {}
};
struct EpiResPart {
    static constexpr bool PERM = false, AFTER_DRAIN = true;
    float* part; const float* mod; int gate_idx; float gscale;
    __device__ __forceinline__ void fused(const f32x4 (&acc)[2][2][4][2], const Unit& u, int wr, int wc, int fr, int fq, PG8_LAS unsigned char*, int, int) const {
        const float* gt = mod + (size_t)2 * (9 * 1024) + gate_idx * 1024;
        const int col0 = u.pn * BM + wc * 32 + 4 * fq;
        float* base = part + ((size_t)u.ks * 512 + (size_t)(u.pm - 64) * BM + wr * 64 + fr) * 1024 + col0;
        f32x4 gv[2][2];
#pragma unroll
        for (int bj = 0; bj < 2; ++bj)
#pragma unroll
            for (int n = 0; n < 2; ++n) gv[bj][n] = *(const f32x4*)(gt + col0 + bj * HALF + n * 16) * gscale;
#pragma unroll
        for (int ai = 0; ai < 2; ++ai)
#pragma unroll
            for (int m = 0; m < 4; ++m) { float* p = base + (size_t)(ai * HALF + m * 16) * 1024;
#pragma unroll
                for (int bj = 0; bj < 2; ++bj)
#pragma unroll
                    for (int n = 0; n < 2; ++n) *(f32x4*)(p + bj * HALF + n * 16) = gv[bj][n] * acc[ai][bj][m][n]; }
    }
};
struct EpiRes {
    static constexpr bool PERM = false, AFTER_DRAIN = false;
    float* hlat; float* hctx; const float* mod; int gate_idx; float gscale;
    __device__ __forceinline__ void operator()(const f32x4 (&acc)[2][2][4][2], const Unit& u, int wr, int wc, int fr, int fq) const {
        const int mi = u.pm < 32 ? 0 : (u.pm < 64 ? 1 : 2);
        const float* gt = mod + (size_t)mi * (9 * 1024) + gate_idx * 1024;
        float* base = u.pm < 64 ? hlat + (size_t)u.pm * BM * 1024 : hctx + (size_t)(u.pm - 64) * BM * 1024;
        const int col0 = u.pn * BM + wc * 32 + 4 * fq;
#pragma unroll
        for (int bj = 0; bj < 2; ++bj)
#pragma unroll
            for (int n = 0; n < 2; ++n) { const f32x4 gv = *(const f32x4*)(gt + col0 + bj * HALF + n * 16) * gscale;
#pragma unroll
                for (int ai = 0; ai < 2; ++ai)
#pragma unroll
                    for (int m = 0; m < 4; ++m) { float* p = base + (size_t)(ai * HALF + wr * 64 + m * 16 + fr) * 1024 + col0 + bj * HALF + n * 16;
                        f32x4 hv = *(const f32x4*)p; hv = hv + gv * acc[ai][bj][m][n]; *(f32x4*)p = hv; } }
    }
};

template <class Epi, class Sched, bool ALIGN_EPI = false, bool SP2 = false>
__device__ __forceinline__ void gemm_phase(PG8_LAS unsigned char* lds, const Gemm g, const Sched& S, const Epi& E) {
    int tid_l = threadIdx.x; asm volatile("" : "+v"(tid_l));
    const int tid = tid_l, wid = __builtin_amdgcn_readfirstlane(tid >> 6), lane = tid & 63, wr = wid >> 2, wc = wid & 3, fr = lane & 15, fq = lane >> 4;
    const int K = g.K, nt = K / BK;
    unsigned voffA[2], voffB[2];
#pragma unroll
    for (int i = 0; i < 2; ++i) { int R, C; stage_rc(tid * 16 + i * 8192, R, C); const int Rb = Epi::PERM ? ((R & ~31) + perm32(R & 31)) : R;
        voffA[i] = (unsigned)(R * g.ld + C) * 2u; voffB[i] = (unsigned)(Rb * g.ld + C) * 2u; }
    const size_t kstep = (size_t)(BK * 2);
    const size_t hstep = (size_t)HALF * g.ld * 2; const size_t kslb = (size_t)K * 2;
    const size_t tstep = 2 * hstep;
    const unsigned ldsw = (unsigned)wid * 1024u;
    const int aoff = lds_byte(wr * 64 + fr, fq * 8), boff = lds_byte(wc * 32 + fr, fq * 8);
#define PG8_SA(b, h) (((b) * 2 + (h)) * HTB)
#define PG8_SB(b, h) ((4 + (b) * 2 + (h)) * HTB)
#define PG8_STAGE(bufoff, gbase, voff) do { _Pragma("unroll") for (int _i = 0; _i < 2; ++_i) \
        __builtin_amdgcn_global_load_lds((const unsigned*)((const char*)(gbase) + (voff)[_i]), (PG8_LAS unsigned*)(lds + (bufoff) + ldsw + _i * 8192), 16, 0, 0); } while (0)
#define PG8_LDA(dst, b, h) do { _Pragma("unroll") for (int m = 0; m < 4; ++m) _Pragma("unroll") for (int k = 0; k < 2; ++k) dst[m][k] = *(const PG8_LAS bf16x8*)(lds + PG8_SA(b, h) + aoff + m * 2048 + k * 1024); } while (0)
#define PG8_LDB(dst, b, h) do { _Pragma("unroll") for (int n = 0; n < 2; ++n) _Pragma("unroll") for (int k = 0; k < 2; ++k) dst[n][k] = *(const PG8_LAS bf16x8*)(lds + PG8_SB(b, h) + boff + n * 2048 + k * 1024); } while (0)
#define PG8_MMA(ai, bj, At, Bt) do { __builtin_amdgcn_s_setprio(1); _Pragma("unroll") for (int m = 0; m < 4; ++m) _Pragma("unroll") for (int n = 0; n < 2; ++n) _Pragma("unroll") for (int k = 0; k < 2; ++k) \
        acc[ai][bj][m][n] = __builtin_amdgcn_mfma_f32_16x16x32_bf16(Bt[n][k], At[m][k], acc[ai][bj][m][n], 0, 0, 0); __builtin_amdgcn_s_setprio(0); } while (0)
#define PG8_WAIT_V(n) asm volatile("s_waitcnt vmcnt(" #n ")" ::: "memory")
#define PG8_WAIT_L(n) asm volatile("s_waitcnt lgkmcnt(" #n ")" ::: "memory")
#define PG8_BAR __builtin_amdgcn_s_barrier()
#define PG8_SCHED __builtin_amdgcn_sched_barrier(0)
    Unit cur, nxt; int ui = 0;
    if (!S.next(0, cur)) return;
    f32x4 acc[2][2][4][2];
#pragma unroll
    for (int a = 0; a < 2; ++a)
#pragma unroll
        for (int b = 0; b < 2; ++b)
#pragma unroll
            for (int m = 0; m < 4; ++m)
#pragma unroll
                for (int n = 0; n < 2; ++n) acc[a][b][m][n] = (f32x4){0.f, 0.f, 0.f, 0.f};
    bf16x8 At[4][2], B0[2][2], B1[2][2];
    const char* cA = (const char*)g.A + (size_t)cur.pm * tstep + (size_t)cur.ks * kslb; const char* cB = (const char*)g.Bt + (size_t)cur.pn * tstep + (size_t)cur.ks * kslb;
    S.a_ready(cur);
    if constexpr (SP2) {
        PG8_STAGE(PG8_SB(0, 0), cB, voffB); PG8_STAGE(PG8_SB(0, 1), cB + hstep, voffB); PG8_STAGE(PG8_SA(0, 0), cA, voffA); PG8_STAGE(PG8_SA(0, 1), cA + hstep, voffA);
        if (wr == 1) PG8_BAR;
        PG8_WAIT_V(2); PG8_BAR;
        PG8_STAGE(PG8_SB(1, 0), cB + kstep, voffB); PG8_STAGE(PG8_SA(1, 0), cA + kstep, voffA); PG8_STAGE(PG8_SB(1, 1), cB + hstep + kstep, voffB);
        PG8_WAIT_V(6); PG8_BAR;
    } else {
        PG8_STAGE(PG8_SB(0, 0), cB, voffB); PG8_STAGE(PG8_SA(0, 0), cA, voffA); PG8_STAGE(PG8_SB(0, 1), cB + hstep, voffB); PG8_STAGE(PG8_SA(0, 1), cA + hstep, voffA);
        if (wr == 1) PG8_BAR;
        PG8_WAIT_V(4); PG8_BAR;
        PG8_STAGE(PG8_SB(1, 0), cB + kstep, voffB); PG8_STAGE(PG8_SA(1, 0), cA + kstep, voffA); PG8_STAGE(PG8_SB(1, 1), cB + hstep + kstep, voffB);
        PG8_WAIT_V(6); PG8_BAR;
    }
    for (;;) {
        const bool has_next = S.next(ui + 1, nxt);
        const char* nA = has_next ? (const char*)g.A + (size_t)nxt.pm * tstep + (size_t)nxt.ks * kslb : cA; const char* nB = has_next ? (const char*)g.Bt + (size_t)nxt.pn * tstep + (size_t)nxt.ks * kslb : cB;
        for (int t = 0; t < nt; t += 2) {
            const bool last = (t == nt - 2);
            const char* a1 = cA + (size_t)(t + 1) * kstep;
            const char* a2 = last ? nA : cA + (size_t)(t + 2) * kstep; const char* b2 = last ? nB : cB + (size_t)(t + 2) * kstep;
            const char* a3 = a2 + kstep; const char* b3 = b2 + kstep;
            if (last && has_next) S.a_ready(nxt);
            if constexpr (SP2) {
            PG8_LDB(B0, 0, 0); PG8_LDB(B1, 0, 1); PG8_SCHED; PG8_LDA(At, 0, 0); PG8_STAGE(PG8_SA(1, 1), a1 + hstep, voffA);
            PG8_WAIT_V(8); PG8_WAIT_L(0); PG8_BAR; PG8_MMA(0, 0, At, B0); PG8_MMA(0, 1, At, B1); PG8_BAR; PG8_SCHED;
            PG8_LDA(At, 0, 1); PG8_STAGE(PG8_SB(0, 0), b2, voffB); PG8_STAGE(PG8_SB(0, 1), b2 + hstep, voffB); PG8_STAGE(PG8_SA(0, 0), a2, voffA);
            PG8_WAIT_V(8); PG8_WAIT_L(0); PG8_BAR; PG8_MMA(1, 0, At, B0); PG8_MMA(1, 1, At, B1); PG8_BAR; PG8_SCHED;
            PG8_LDB(B0, 1, 0); PG8_LDB(B1, 1, 1); PG8_SCHED; PG8_LDA(At, 1, 0); PG8_STAGE(PG8_SA(0, 1), a2 + hstep, voffA);
            PG8_WAIT_V(8); PG8_WAIT_L(0); PG8_BAR; PG8_MMA(0, 0, At, B0); PG8_MMA(0, 1, At, B1); PG8_BAR; PG8_SCHED;
            PG8_LDA(At, 1, 1); PG8_STAGE(PG8_SB(1, 0), b3, voffB); PG8_STAGE(PG8_SB(1, 1), b3 + hstep, voffB); PG8_STAGE(PG8_SA(1, 0), a3, voffA);
            PG8_WAIT_V(8); PG8_WAIT_L(0); PG8_BAR; PG8_MMA(1, 0, At, B0); PG8_MMA(1, 1, At, B1); PG8_BAR; PG8_SCHED;
            } else {
            PG8_LDB(B0, 0, 0); PG8_SCHED; PG8_LDA(At, 0, 0); PG8_STAGE(PG8_SA(1, 1), a1 + hstep, voffA);
            PG8_WAIT_L(8); PG8_BAR; PG8_WAIT_L(0); PG8_MMA(0, 0, At, B0); PG8_BAR; PG8_SCHED;
            PG8_LDB(B1, 0, 1); PG8_STAGE(PG8_SB(0, 0), b2, voffB);
            PG8_BAR; PG8_WAIT_L(0); PG8_MMA(0, 1, At, B1); PG8_BAR;
            PG8_LDA(At, 0, 1); PG8_STAGE(PG8_SA(0, 0), a2, voffA);
            PG8_BAR; PG8_WAIT_L(0); PG8_MMA(1, 0, At, B0); PG8_BAR; PG8_SCHED;
            PG8_STAGE(PG8_SB(0, 1), b2 + hstep, voffB);
            PG8_WAIT_V(6); PG8_BAR; PG8_MMA(1, 1, At, B1); PG8_BAR;
            PG8_LDB(B0, 1, 0); PG8_SCHED; PG8_LDA(At, 1, 0); PG8_STAGE(PG8_SA(0, 1), a2 + hstep, voffA);
            PG8_WAIT_L(8); PG8_BAR; PG8_WAIT_L(0); PG8_MMA(0, 0, At, B0); PG8_BAR; PG8_SCHED;
            PG8_LDB(B1, 1, 1); PG8_STAGE(PG8_SB(1, 0), b3, voffB);
            PG8_BAR; PG8_WAIT_L(0); PG8_MMA(0, 1, At, B1); PG8_BAR;
            PG8_LDA(At, 1, 1); PG8_STAGE(PG8_SA(1, 0), a3, voffA);
            PG8_BAR; PG8_WAIT_L(0); PG8_MMA(1, 0, At, B0); PG8_BAR; PG8_SCHED;
            PG8_STAGE(PG8_SB(1, 1), b3 + hstep, voffB);
            PG8_WAIT_V(6); PG8_BAR; PG8_MMA(1, 1, At, B1); PG8_BAR;
            }
        }
        if constexpr (ALIGN_EPI) { if (wr == 0) PG8_BAR; }
        if constexpr (!Epi::AFTER_DRAIN) { E(acc, cur, wr, wc, fr, fq); S.done(cur); }
        if (!has_next) break;
#pragma unroll
        for (int a = 0; a < 2; ++a)
#pragma unroll
            for (int b = 0; b < 2; ++b)
#pragma unroll
                for (int m = 0; m < 4; ++m)
#pragma unroll
                    for (int n = 0; n < 2; ++n) acc[a][b][m][n] = (f32x4){0.f, 0.f, 0.f, 0.f};
        cur = nxt; cA = nA; cB = nB; ++ui;
        if constexpr (ALIGN_EPI) { if (wr == 1) PG8_BAR; }
    }
    PG8_WAIT_V(0);
    if constexpr (!ALIGN_EPI) { if (wr == 0) PG8_BAR; }
    PG8_BAR;
    if constexpr (Epi::AFTER_DRAIN) { E.fused(acc, cur, wr, wc, fr, fq, lds, wid, lane); S.done(cur); }
#undef PG8_SA
#undef PG8_SB
#undef PG8_STAGE
#undef PG8_LDA
#undef PG8_LDB
#undef PG8_MMA
#undef PG8_WAIT_V
#undef PG8_WAIT_L
#undef PG8_BAR
#undef PG8_SCHED
}
}
#include <hip/hip_bf16.h>
#include <cmath>
namespace attn_body {
using bf16=__hip_bfloat16;
using bf16x8=__attribute__((ext_vector_type(8)))short;
using s16x4=__attribute__((ext_vector_type(4)))short;
using f32x16=__attribute__((ext_vector_type(16)))float;
using u32x4=__attribute__((ext_vector_type(4)))unsigned;
constexpr int D=64,QP=512,KP=128,OP=1024;
constexpr int NW=8,QBLK=32,QB=QBLK*NW,KVBLK=64;
__device__ __forceinline__ int crow(int r,int hi){return (r&3)+8*(r>>2)+4*hi;}
#define SBAR() __builtin_amdgcn_sched_barrier(0)
constexpr int NSLOT=3, SLOTB=8192;
constexpr int LDS_K=0, LDS_V=NSLOT*SLOTB, LDS_WS=2*NSLOT*SLOTB, LDS_OST=LDS_WS+NW*64*4, LDS_BYTES=LDS_OST+NW*4096;
constexpr float C2=0.125f*1.4426950408889634f;
__device__ __forceinline__ void glds16(const void*gsrc,unsigned lds_dst){unsigned keep;
  asm volatile("s_mov_b32 %0, m0\n\ts_mov_b32 m0, %2\n\ts_nop 0\n\tglobal_load_lds_dwordx4 %1, off\n\ts_mov_b32 m0, %0":"=&s"(keep):"v"(gsrc),"s"(lds_dst):"memory");}
__device__ __forceinline__ float max3f(float a,float b,float c){float r;asm("v_max3_f32 %0, %1, %2, %3":"=v"(r):"v"(a),"v"(b),"v"(c));return r;}
__device__ __forceinline__ float max2f(float a,float b){float r;asm("v_max_f32_e32 %0, %1, %2":"=v"(r):"v"(a),"v"(b));return r;}
__device__ __forceinline__ float fadd_s(float a,float b){float r;asm("v_add_f32_e32 %0, %1, %2":"=v"(r):"v"(a),"v"(b));return r;}
__device__ __forceinline__ float fsub_s(float a,float b){float r;asm("v_sub_f32_e32 %0, %1, %2":"=v"(r):"v"(a),"v"(b));return r;}
typedef float f32x2_t __attribute__((ext_vector_type(2))); typedef __bf16 bf16x2_t __attribute__((ext_vector_type(2)));
__device__ __forceinline__ unsigned cvtpk_s(float lo,float hi){f32x2_t v={lo,hi};bf16x2_t b=__builtin_convertvector(v,bf16x2_t);return __builtin_bit_cast(unsigned,b);}
#define WAIT_BAR(N) asm volatile("s_waitcnt vmcnt(" #N ") lgkmcnt(0)\n\ts_barrier":::"memory")

__device__ __forceinline__ void qkt(f32x16&p0,f32x16&p1,const char*Kslot,const bf16x8*qr,const f32x16&negm,int r32,int hi){
  const char*kb=Kslot+hi*1024+r32*16;
  #pragma unroll
  for(int d0=0;d0<4;++d0){
    const bf16x8 b0=*reinterpret_cast<const bf16x8*>(kb+d0*2048);
    const bf16x8 b1=*reinterpret_cast<const bf16x8*>(kb+d0*2048+512);
    if(d0==0){p0=__builtin_amdgcn_mfma_f32_32x32x16_bf16(b0,qr[0],negm,0,0,0);p1=__builtin_amdgcn_mfma_f32_32x32x16_bf16(b1,qr[0],negm,0,0,0);}
    else{p0=__builtin_amdgcn_mfma_f32_32x32x16_bf16(b0,qr[d0],p0,0,0,0);p1=__builtin_amdgcn_mfma_f32_32x32x16_bf16(b1,qr[d0],p1,0,0,0);}}
}
typedef __attribute__((address_space(3))) const char* lds_cptr;
typedef short v4i16_t __attribute__((ext_vector_type(4)));
__device__ __forceinline__ void kload8(bf16x8*kf,lds_cptr kp){
  kf[0]=*(const __attribute__((address_space(3))) bf16x8*)(kp);      kf[1]=*(const __attribute__((address_space(3))) bf16x8*)(kp+512);
  kf[2]=*(const __attribute__((address_space(3))) bf16x8*)(kp+2048); kf[3]=*(const __attribute__((address_space(3))) bf16x8*)(kp+2560);
  kf[4]=*(const __attribute__((address_space(3))) bf16x8*)(kp+4096); kf[5]=*(const __attribute__((address_space(3))) bf16x8*)(kp+4608);
  kf[6]=*(const __attribute__((address_space(3))) bf16x8*)(kp+6144); kf[7]=*(const __attribute__((address_space(3))) bf16x8*)(kp+6656);
}
__device__ __forceinline__ void kload2(bf16x8*kf,lds_cptr kp,int j){ kf[2*j]=*(const __attribute__((address_space(3))) bf16x8*)(kp+j*2048); kf[2*j+1]=*(const __attribute__((address_space(3))) bf16x8*)(kp+j*2048+512); }
__device__ __forceinline__ s16x4 vtr(lds_cptr p){ return __builtin_bit_cast(s16x4,__builtin_amdgcn_ds_read_tr16_b64_v4i16((__attribute__((address_space(3))) v4i16_t*)p)); }
__device__ __forceinline__ float rowmax(const f32x16&p0,const f32x16&p1){
  float a=max3f(p0[0],p0[1],p1[0]),b=max3f(p0[2],p0[3],p1[1]);a=max3f(a,p1[2],p1[3]);
  #pragma unroll
  for(int r=4;r<16;r+=4){a=max3f(a,p0[r],p0[r+1]);b=max3f(b,p0[r+2],p0[r+3]);a=max3f(a,p1[r],p1[r+1]);b=max3f(b,p1[r+2],p1[r+3]);}
  const float m=max2f(a,b);
  auto rr=__builtin_amdgcn_permlane32_swap(__float_as_uint(m),__float_as_uint(m),false,false);
  return max2f(__uint_as_float(rr[0]),__uint_as_float(rr[1]));
}
__device__ __forceinline__ void pv(f32x16*o,int vb,bf16x8 pa0,bf16x8 pa1,bf16x8 pa2,bf16x8 pa3){
  #pragma unroll
  for(int d0=0;d0<2;++d0){s16x4 lo[4],hi[4];
    #pragma unroll
    for(int ks=0;ks<4;++ks){
      asm volatile("ds_read_b64_tr_b16 %0,%1 offset:%c2":"=&v"(lo[ks]):"v"(vb),"i"(d0*4096+ks*1024):"memory");
      asm volatile("ds_read_b64_tr_b16 %0,%1 offset:%c2":"=&v"(hi[ks]):"v"(vb),"i"(d0*4096+ks*1024+512):"memory");}
    asm volatile("s_waitcnt lgkmcnt(0)":::"memory");SBAR();
    #define PK(k) (bf16x8){lo[k][0],lo[k][1],lo[k][2],lo[k][3],hi[k][0],hi[k][1],hi[k][2],hi[k][3]}
    o[d0]=__builtin_amdgcn_mfma_f32_32x32x16_bf16(pa0,PK(0),o[d0],0,0,0);
    o[d0]=__builtin_amdgcn_mfma_f32_32x32x16_bf16(pa1,PK(1),o[d0],0,0,0);
    o[d0]=__builtin_amdgcn_mfma_f32_32x32x16_bf16(pa2,PK(2),o[d0],0,0,0);
    o[d0]=__builtin_amdgcn_mfma_f32_32x32x16_bf16(pa3,PK(3),o[d0],0,0,0);
    #undef PK
  }
}

#ifndef ATTN_STORE16
#define ATTN_STORE16(p,v) (*(u32x4*)(p)=(v))
#endif
template<int THRL> __device__ __forceinline__ void attn_unit(long qrow0,int h,long kvbase,int nkeys,const bf16*Q,const bf16*__restrict__ K,const bf16*__restrict__ V,bf16*O,char*shm){
  int tid=threadIdx.x; asm volatile("":"+v"(tid)); const int lane=tid&63,r32=lane&31,hi=lane>>5; const int wid=__builtin_amdgcn_readfirstlane(tid>>6);
  const bf16*Qw=Q+(qrow0+wid*QBLK)*QP+h*D;
  const bf16*Kh=K+kvbase*KP+(h>>2)*D,*Vh=V+kvbase*KP+(h>>2)*D;
  const unsigned lds0=(unsigned)(uintptr_t)shm;
  float*wsf=(float*)(shm+LDS_WS)+wid*64;
  const bf16*ksrc=Kh+(long)lane*KP+wid*8;
  const bf16*vsrc=Vh+(long)(16*(wid&3)+(lane>>2))*KP+(wid>>2)*32+(lane&3)*8;
  const unsigned kdst=lds0+LDS_K+wid*1024, vdst=lds0+LDS_V+wid*1024;
  #define DMA_K(t,slot) glds16(ksrc+(long)(t)*KVBLK*KP,(unsigned)__builtin_amdgcn_readfirstlane(kdst+(slot)))
  #define DMA_V(t,slot) glds16(vsrc+(long)(t)*KVBLK*KP,(unsigned)__builtin_amdgcn_readfirstlane(vdst+(slot)))
  const int vb0=(int)(lds0+LDS_V)+((lane>>4)&1)*32+(lane&3)*8+(4*hi+((lane&15)>>2))*64;
  const char*Kbase=shm+LDS_K; bf16x8 kf[8];
  const lds_cptr shm3=(lds_cptr)shm; const lds_cptr kp0=shm3+LDS_K+hi*1024+r32*16; const lds_cptr vp0=shm3+LDS_V+((lane>>4)&1)*32+(lane&3)*8+(4*hi+((lane&15)>>2))*64;
  const int NT=nkeys/KVBLK;
  DMA_K(0,0);DMA_V(0,0);DMA_K(1,SLOTB);
  bf16x8 qr[4];
  #pragma unroll
  for(int d0=0;d0<4;++d0)qr[d0]=*reinterpret_cast<const bf16x8*>(&Qw[(long)r32*QP+d0*16+hi*8]);
  float mhat=0.f,l_reg=0.f;f32x16 o[2];o[0]=f32x16{};o[1]=f32x16{};f32x16 negm=f32x16{};asm volatile("":"+v"(negm));
  #define CMASK(P0,P1,t) do{}while(0)
  bool resc=false;
  #define START(P0,P1) do{ const float rm=rowmax(P0,P1); resc=false; \
    { const float dl=rm; mhat=fadd_s(mhat,dl); \
      _Pragma("unroll") for(int r=0;r<16;++r){P0[r]=fsub_s(P0[r],dl);P1[r]=fsub_s(P1[r],dl);} \
      _Pragma("unroll") for(int r=0;r<16;++r)negm[r]=-mhat; asm volatile("":"+v"(negm)); } \
    _Pragma("unroll") for(int r=0;r<16;++r)P0[r]=__builtin_amdgcn_exp2f(P0[r]); }while(0)
  #define RESC() do{ if(resc){ asm volatile("s_waitcnt lgkmcnt(0)":::"memory"); \
      _Pragma("unroll") for(int d_=0;d_<2;++d_) _Pragma("unroll") for(int r=0;r<16;++r)o[d_][r]*=wsf[crow(r,hi)]; } }while(0)
  f32x16 pA0,pA1,pB0,pB1;
  int sl_prev=0,sl_cur=0,sl_next=SLOTB;
  #define ROT() do{sl_prev=sl_cur;sl_cur=sl_next;sl_next=(sl_next==(NSLOT-1)*SLOTB)?0:sl_next+SLOTB;}while(0)
  DMA_K(2,2*SLOTB);
  WAIT_BAR(3);
  qkt(pA0,pA1,Kbase,qr,negm,r32,hi);asm volatile("s_nop 15\n\ts_nop 7":"+v"(pA0),"+v"(pA1));CMASK(pA0,pA1,0);
  START(pA0,pA1);
  _Pragma("unroll") for(int r=0;r<16;++r)pA1[r]=__builtin_amdgcn_exp2f(pA1[r]);
  WAIT_BAR(0);
  DMA_K(3,0);DMA_V(1,SLOTB);
  ROT();
  kload8(kf,kp0+sl_cur);
  WAIT_BAR(2);
  s16x4 vlo[8],vhi[8]; u32x4 pw0,pw1,pw2,pw3;
  #define PKW(P,B) cvtpk_s(P[B],P[B+1])
  #define PAF(k) __builtin_bit_cast(bf16x8,pw##k)
  #define VFR(i) (bf16x8){vlo[i][0],vlo[i][1],vlo[i][2],vlo[i][3],vhi[i][0],vhi[i][1],vhi[i][2],vhi[i][3]}
  #define PIN(x) asm volatile("":"+v"(x))
  #define MX3(a,b,c) __builtin_fmaxf(__builtin_fmaxf((a),(b)),(c))
  #define GAPA(MF,A0,A1,A2,A3,W0,W1,PW) do{ MF; sacc+=A0; sacc+=A1; sacc+=A2; sacc+=A3; PIN(sacc); W0; W1; PIN(PW); SBAR(); }while(0)
  #define EX(v) __builtin_amdgcn_exp2f(v)
  #define GAPB(MF,X,B) do{ MF; X[B]=EX(X[B]); X[B+1]=EX(X[B+1]); X[B+2]=EX(X[B+2]); X[B+3]=EX(X[B+3]); PIN(X); SBAR(); }while(0)
  #define VRD(i) do{ vlo[i]=vtr(vp_+(((i)>>2)*4096+((i)&3)*1024)); vhi[i]=vtr(vp_+(((i)>>2)*4096+((i)&3)*1024+512)); }while(0)
  #define KRD(G,j) do{ if(G){ kload2(kf,kp0+sl_next,j); SBAR(); } }while(0)
  #define STEP(C0,C1,P0,P1,t,GK,GV,GL) do{ SBAR(); \
    const lds_cptr vp_=vp0+sl_prev; \
    VRD(0); SBAR(); float sacc=(P0[0]+P0[1]); \
    GAPA(C0=__builtin_amdgcn_mfma_f32_32x32x16_bf16(kf[0],qr[0],negm,0,0,0), P0[2],P0[3],P0[4],P0[5],     pw0[0]=PKW(P0,0), pw0[1]=PKW(P0,2), pw0); \
    VRD(4); SBAR(); GAPA(C1=__builtin_amdgcn_mfma_f32_32x32x16_bf16(kf[1],qr[0],negm,0,0,0), P0[6],P0[7],P0[8],P0[9],     pw0[2]=PKW(P0,4), pw0[3]=PKW(P0,6), pw0); \
    VRD(1); SBAR(); GAPA(C0=__builtin_amdgcn_mfma_f32_32x32x16_bf16(kf[2],qr[1],C0,0,0,0),   P0[10],P0[11],P0[12],P0[13], pw1[0]=PKW(P0,8), pw1[1]=PKW(P0,10), pw1); \
    VRD(5); SBAR(); GAPA(C1=__builtin_amdgcn_mfma_f32_32x32x16_bf16(kf[3],qr[1],C1,0,0,0),   P0[14],P0[15],P1[0],P1[1],   pw1[2]=PKW(P0,12),pw1[3]=PKW(P0,14), pw1); \
    VRD(2); SBAR(); GAPA(C0=__builtin_amdgcn_mfma_f32_32x32x16_bf16(kf[4],qr[2],C0,0,0,0),   P1[2],P1[3],P1[4],P1[5],     pw2[0]=PKW(P1,0), pw2[1]=PKW(P1,2), pw2); \
    VRD(6); SBAR(); GAPA(C1=__builtin_amdgcn_mfma_f32_32x32x16_bf16(kf[5],qr[2],C1,0,0,0),   P1[6],P1[7],P1[8],P1[9],     pw2[2]=PKW(P1,4), pw2[3]=PKW(P1,6), pw2); \
    VRD(3); SBAR(); GAPA(C0=__builtin_amdgcn_mfma_f32_32x32x16_bf16(kf[6],qr[3],C0,0,0,0),   P1[10],P1[11],P1[12],P1[13], pw3[0]=PKW(P1,8), pw3[1]=PKW(P1,10), pw3); \
    VRD(7); SBAR(); GAPA(C1=__builtin_amdgcn_mfma_f32_32x32x16_bf16(kf[7],qr[3],C1,0,0,0),   P1[14],P1[15],0.f,0.f,       pw3[2]=PKW(P1,12),pw3[3]=PKW(P1,14), pw3); \
    l_reg+=sacc; \
    if(GK){DMA_K((t)+3,sl_cur);} if(GV){DMA_V((t)+1,sl_next);} \
    CMASK(C0,C1,t); \
    { float a=MX3(C0[0],C0[1],C1[0]),b=MX3(C0[2],C0[3],C1[1]); a=MX3(a,C1[2],C1[3]); \
      _Pragma("unroll") for(int r=4;r<16;r+=4){a=MX3(a,C0[r],C0[r+1]);b=MX3(b,C0[r+2],C0[r+3]);a=MX3(a,C1[r],C1[r+1]);b=MX3(b,C1[r+2],C1[r+3]);} \
      float rm=__builtin_fmaxf(a,b); { auto rr=__builtin_amdgcn_permlane32_swap(__float_as_uint(rm),__float_as_uint(rm),false,false); rm=__builtin_fmaxf(__uint_as_float(rr[0]),__uint_as_float(rr[1])); } \
      resc=false; \
      if(__builtin_expect(__any(rm>(float)THRL),0)){ const float dl=__builtin_fmaxf(rm,0.f); mhat+=dl; \
        _Pragma("unroll") for(int r=0;r<16;++r){C0[r]-=dl;C1[r]-=dl;} \
        _Pragma("unroll") for(int r=0;r<16;++r)negm[r]=-mhat; asm volatile("":"+v"(negm)); \
        const float f=__builtin_amdgcn_exp2f(-dl); l_reg*=f; if(hi==0)wsf[r32]=f; resc=true; } } \
    SBAR(); \
    GAPB(o[0]=__builtin_amdgcn_mfma_f32_32x32x16_bf16(PAF(0),VFR(0),o[0],0,0,0), C0,0); \
    GAPB(o[1]=__builtin_amdgcn_mfma_f32_32x32x16_bf16(PAF(0),VFR(4),o[1],0,0,0), C0,4); \
    KRD(GL,0); GAPB(o[0]=__builtin_amdgcn_mfma_f32_32x32x16_bf16(PAF(1),VFR(1),o[0],0,0,0), C0,8); \
    KRD(GL,1); GAPB(o[1]=__builtin_amdgcn_mfma_f32_32x32x16_bf16(PAF(1),VFR(5),o[1],0,0,0), C0,12); \
    KRD(GL,2); GAPB(o[0]=__builtin_amdgcn_mfma_f32_32x32x16_bf16(PAF(2),VFR(2),o[0],0,0,0), C1,0); \
    KRD(GL,3); GAPB(o[1]=__builtin_amdgcn_mfma_f32_32x32x16_bf16(PAF(2),VFR(6),o[1],0,0,0), C1,4); \
    GAPB(o[0]=__builtin_amdgcn_mfma_f32_32x32x16_bf16(PAF(3),VFR(3),o[0],0,0,0), C1,8); \
    GAPB(o[1]=__builtin_amdgcn_mfma_f32_32x32x16_bf16(PAF(3),VFR(7),o[1],0,0,0), C1,12); \
    }while(0)
  int t=1;
  #undef CMASK
  #define CMASK(P0,P1,t) do{}while(0)
  for(;t+5<NT;t+=2){
    STEP(pB0,pB1,pA0,pA1,t,true,true,true);     WAIT_BAR(2); RESC(); ROT();
    STEP(pA0,pA1,pB0,pB1,t+1,true,true,true);   WAIT_BAR(2); RESC(); ROT();
  }
  #undef CMASK
  #define CMASK(P0,P1,t) do{}while(0)
  #define ENDW(tt) do{ if((tt)+3<NT){WAIT_BAR(2);} else if((tt)+2<NT){WAIT_BAR(1);} else {WAIT_BAR(0);} }while(0)
  for(;t+1<NT;t+=2){
    STEP(pB0,pB1,pA0,pA1,t,(t+3<NT),(t+1<NT),(t+1<NT));       ENDW(t);   RESC(); ROT();
    STEP(pA0,pA1,pB0,pB1,t+1,(t+4<NT),(t+2<NT),(t+2<NT));     ENDW(t+1); RESC(); ROT();
  }
  STEP(pB0,pB1,pA0,pA1,NT-1,false,false,false); RESC();
  { float sacc=pB0[0]+pB0[1]; _Pragma("unroll") for(int r=2;r<16;++r)sacc+=pB0[r]; _Pragma("unroll") for(int r=0;r<16;++r)sacc+=pB1[r]; l_reg+=sacc;
    pw0=(u32x4){PKW(pB0,0),PKW(pB0,2),PKW(pB0,4),PKW(pB0,6)};pw1=(u32x4){PKW(pB0,8),PKW(pB0,10),PKW(pB0,12),PKW(pB0,14)};pw2=(u32x4){PKW(pB1,0),PKW(pB1,2),PKW(pB1,4),PKW(pB1,6)};pw3=(u32x4){PKW(pB1,8),PKW(pB1,10),PKW(pB1,12),PKW(pB1,14)};
    SBAR(); pv(o,vb0+sl_cur,PAF(0),PAF(1),PAF(2),PAF(3)); }
  #undef PKW
  #undef PAF
  #undef VFR
  #undef PIN
  #undef MX3
  #undef GAPA
  #undef GAPB
  #undef EX
  #undef VRD
  #undef KRD
  #undef STEP
  #undef ENDW
  {auto rr=__builtin_amdgcn_permlane32_swap(__float_as_uint(l_reg),__float_as_uint(l_reg),false,false);l_reg=__uint_as_float(rr[0])+__uint_as_float(rr[1]);}
  if(hi==0)wsf[32+r32]=l_reg;asm volatile("s_waitcnt lgkmcnt(0)":::"memory");
  float rli[16];
  #pragma unroll
  for(int r=0;r<16;++r)rli[r]=__builtin_amdgcn_rcpf(wsf[32+crow(r,hi)]);
  bf16*Ow=O+(qrow0+wid*QBLK)*OP+h*D;
  { bf16*stg=(bf16*)(shm+LDS_OST)+wid*2048;
    #pragma unroll
    for(int r=0;r<16;++r){const int orow=crow(r,hi);
      #pragma unroll
      for(int d0=0;d0<2;++d0)stg[orow*64+d0*32+r32]=__float2bfloat16(o[d0][r]*rli[r]);}
    asm volatile("s_waitcnt lgkmcnt(0)":::"memory");
    #pragma unroll
    for(int i=0;i<4;++i){const int row=i*8+(lane>>3),ch=lane&7; const u32x4 v=*(const u32x4*)(stg+row*64+ch*8); ATTN_STORE16(Ow+(long)row*OP+ch*8,v);} }
  asm volatile("s_waitcnt lgkmcnt(0)\n\ts_barrier":::"memory");
  #undef DMA_K
  #undef DMA_V
  #undef CMASK
  #undef START
  #undef RESC
  #undef ROT
}
constexpr int ATTN_LDS_BYTES=LDS_BYTES;
#undef SBAR
#undef WAIT_BAR
}

#define REP_HY 1
#define REP_GQA 1
#define REP_NA 1
#define REP_NORM 1
#define REP_POST 1
#define REP_SYNC 1
#define REP_UP 1
#define REP_SK 1
#define REP_OUT 1
#define REP_GC 1
#define REP_F 1
#define REP_A 1
#define REP_IN 1
#define REP_W 1
#define REP_DOWN 1
#define REP_HYC 1
#define GRID_SYNC() do { for (int rs_ = 0; rs_ < REP_SYNC; ++rs_) xcd_barrier(xbar); } while (0)
#define LAS __attribute__((address_space(3)))
constexpr int LDS_BYTES = 131072 + 1024;
constexpr int NTHREADS = 512, NWAVES = 8;

__device__ __forceinline__ void p0_transpose_item(const float* __restrict__ W, int K, int N, bf16_t* __restrict__ WT, int mode, float* scr, int item, int lane) {
    const int nblk = N / 32, kb = item / nblk, nb = item % nblk, k0 = 64 * kb, n0 = 32 * nb;
    float tv[32];
#pragma unroll
    for (int i = 0; i < 32; ++i) tv[i] = W[(size_t)(k0 + 2 * i + (lane >> 5)) * N + n0 + (lane & 31)];
#pragma unroll
    for (int i = 0; i < 32; ++i) scr[(2 * i + (lane >> 5)) * 33 + (lane & 31)] = tv[i];
    asm volatile("s_waitcnt lgkmcnt(0)" ::: "memory");
    const int c = lane & 7;
#pragma unroll
    for (int j = 0; j < 4; ++j) { const int nl = (lane >> 3) + 8 * j; const float* s = scr + (8 * c) * 33 + nl;
        u32x4 o; o.x = pk2(s[0 * 33], s[1 * 33]); o.y = pk2(s[2 * 33], s[3 * 33]); o.z = pk2(s[4 * 33], s[5 * 33]); o.w = pk2(s[6 * 33], s[7 * 33]);
        const int n = n0 + nl;
        const int r = mode == 0 ? n : ((n >> 7) * 256 + (n & 127) + (mode == 2 ? 128 : 0));
        *(u32x4*)(WT + (size_t)r * K + k0 + 8 * c) = o; }
    asm volatile("s_waitcnt lgkmcnt(0)" ::: "memory");
}

struct MegaArgs { const float* in[31]; float* out; unsigned char* ws; };

__device__ __forceinline__ void p0_weights(const MegaArgs& a, unsigned char* lds, int it_lo, int it_hi, int wave, int lane) {
    float* scr = (float*)(lds + wave * 8448);
    constexpr int I_G = (D / 64) * (FF / 32), I_D = (FF / 64) * (D / 32), I_IN = (D / 64) * (INW / 32), I_OUT = (D / 64) * (D / 32);
    constexpr int I_LAYER = 4 * I_G + 2 * I_D + I_IN + I_OUT;
    unsigned char* ws = a.ws;
    for (int it = it_lo; it < it_hi; ++it) {
        const int l = it / I_LAYER; int r = it % I_LAYER;
        bool done = false;
#pragma unroll
        for (int f = 0; f < 2; ++f) {
            if (done) break;
            bf16_t* gu = (bf16_t*)(ws + WS_WGU) + (size_t)(l * 2 + f) * 2 * FF * D; bf16_t* dn = (bf16_t*)(ws + WS_WD) + (size_t)(l * 2 + f) * D * FF;
            const float* wg = (f == 0 ? a.in[7] : a.in[28]) + (size_t)l * D * FF; const float* wu = (f == 0 ? a.in[8] : a.in[29]) + (size_t)l * D * FF; const float* wd = (f == 0 ? a.in[9] : a.in[30]) + (size_t)l * FF * D;
            if (r < I_G) { p0_transpose_item(wg, D, FF, gu, 1, scr, r, lane); done = true; break; } r -= I_G;
            if (r < I_G) { p0_transpose_item(wu, D, FF, gu, 2, scr, r, lane); done = true; break; } r -= I_G;
            if (r < I_D) { p0_transpose_item(wd, FF, D, dn, 0, scr, r, lane); done = true; break; } r -= I_D;
        }
        if (done) continue;
        if (r < I_IN) { p0_transpose_item(a.in[11] + (size_t)l * D * INW, D, INW, (bf16_t*)(ws + WS_WIN) + (size_t)l * INW * D, 0, scr, r, lane); continue; } r -= I_IN;
        p0_transpose_item(a.in[12] + (size_t)l * D * D, D, D, (bf16_t*)(ws + WS_WOUT) + (size_t)l * D * D, 0, scr, r, lane);
    }
}

__device__ __forceinline__ void p0_adaln(const MegaArgs& a, const float* sc  , int it_lo, int it_hi, int lane) {
    const float* w = a.in[4]; const float* b = a.in[5]; float* mod = (float*)(a.ws + WS_MOD);
    constexpr int NCG = NMOD * D / 256;
    for (int it = it_lo; it < it_hi; ++it) {
        const int ks = it & 15, cgi = (it >> 4) % NCG, l = (it >> 4) / NCG;
        const int j = cgi * 256 + 4 * lane;
        const float* wl = w + (size_t)l * D * (NMOD * D) + (size_t)(ks * 64) * (NMOD * D) + j;
        f32x4 s0 = (f32x4){0.f, 0.f, 0.f, 0.f}, s1 = s0, s2 = s0;
#pragma unroll 16
        for (int k = 0; k < 64; ++k) { const f32x4 wv = *(const f32x4*)(wl + (size_t)k * (NMOD * D)); const int kk = ks * 64 + k; s0 += wv * sc[kk]; s1 += wv * sc[D + kk]; s2 += wv * sc[2 * D + kk]; }
        if (ks == 0) { const f32x4 bv = *(const f32x4*)(b + (size_t)l * NMOD * D + j); s0 += bv; s1 += bv; s2 += bv; }
        float* m = mod + (size_t)l * 3 * NMOD * D + j;
#pragma unroll
        for (int e = 0; e < 4; ++e) { atomicAdd(m + e, s0[e] * (1.0f / REP_A)); atomicAdd(m + NMOD * D + e, s1[e] * (1.0f / REP_A)); atomicAdd(m + 2 * NMOD * D + e, s2[e] * (1.0f / REP_A)); }
    }
}

#define FLT_LOAD(r, base, stride, nrows) do { _Pragma("unroll") for (int q_ = 0; q_ < 4; ++q_) { const int row_ = (lane >> 2) + 16 * q_; r[q_] = row_ < (nrows) ? *(const f32x4*)((base) + (size_t)row_ * (stride) + 4 * (lane & 3)) : (f32x4){0.f, 0.f, 0.f, 0.f}; } } while (0)
#define FLT_STORE(r) do { _Pragma("unroll") for (int q_ = 0; q_ < 4; ++q_) *(f32x4*)(wb + ((lane >> 2) + 16 * q_) * 16 + 4 * (lane & 3)) = r[q_]; } while (0)
#define FLT_FMA16(f, k) do { const f32x4 w0_ = *(const f32x4*)(wb + (k) * 16), w1_ = *(const f32x4*)(wb + (k) * 16 + 4), w2_ = *(const f32x4*)(wb + (k) * 16 + 8), w3_ = *(const f32x4*)(wb + (k) * 16 + 12); \
    _Pragma("unroll") for (int j_ = 0; j_ < 4; ++j_) { acc[j_] += (f) * w0_[j_]; acc[4 + j_] += (f) * w1_[j_]; acc[8 + j_] += (f) * w2_[j_]; acc[12 + j_] += (f) * w3_[j_]; } } while (0)
__device__ __forceinline__ void p0_filter_item(const MegaArgs& a, float* sm  , float* wb  , int pitem, bool active, int t256) {
    float (*feats)[33] = (float (*)[33])sm;
    float (*h1)[65] = (float (*)[65])(sm + 64 * 33);
    float (*h2)[65] = (float (*)[65])(sm + 64 * 33 + 64 * 65);
    const int l = active ? pitem / 132 : 0;
    int pb = active ? pitem % 132 : 0;
    const bool isctx = pb >= SEQ / 64;
    const int n = isctx ? CTX : SEQ;
    if (isctx) pb -= SEQ / 64;
    const int lane = t256 & 63, w = __builtin_amdgcn_readfirstlane(t256 >> 6);
    const int p = pb * 64 + lane;
    const float t = (float)p / (float)(n - 1);
    if (w == 0) {
        feats[lane][0] = t;
        for (int i = 0; i < 16; ++i) {
            const float band = 1e-4f + (float)i * ((15.0f - 1e-4f) / 15.0f);
            float rev = (float)p * band / (float)n; rev = rev - floorf(rev);
            feats[lane][1 + i] = __builtin_amdgcn_cosf(rev); feats[lane][17 + i] = -__builtin_amdgcn_sinf(rev);
        }
    }
    __syncthreads();
    const float* W1 = a.in[17] + (size_t)l * 33 * 64; const float* B1 = a.in[18] + l * 64; const float* W2 = a.in[19] + (size_t)l * 64 * 64; const float* B2 = a.in[20] + l * 64;
    const float* W3 = a.in[21] + (size_t)l * 64 * 512; const float* FR = a.in[22] + l * 64;
    float* KF = (float*)(a.ws + WS_KF); float* KFC = (float*)(a.ws + WS_KFC); float* fnorm = (float*)(a.ws + WS_FNORM);
    {
        float acc[16];
#pragma unroll
        for (int j = 0; j < 16; ++j) acc[j] = B1[16 * w + j];
        { f32x4 r[4]; FLT_LOAD(r, W1 + 16 * w, 64, 33); FLT_STORE(r); }
#pragma unroll 3
        for (int k = 0; k < 33; ++k) { const float f = feats[lane][k]; FLT_FMA16(f, k); }
#pragma unroll
        for (int j = 0; j < 16; ++j) h1[lane][16 * w + j] = fast_sin(FR[16 * w + j] * acc[j]);
    }
    __syncthreads();
    {
        float acc[16];
#pragma unroll
        for (int j = 0; j < 16; ++j) acc[j] = B2[16 * w + j];
        { f32x4 r[4]; FLT_LOAD(r, W2 + 16 * w, 64, 64); FLT_STORE(r); }
#pragma unroll 4
        for (int k = 0; k < 64; ++k) { const float f = h1[lane][k]; FLT_FMA16(f, k); }
#pragma unroll
        for (int j = 0; j < 16; ++j) h2[lane][16 * w + j] = fast_sin(FR[16 * w + j] * acc[j]);
    }
    __syncthreads();
    const float dlo = logf(1e-2f) / 1.5f, dhi = logf(1e-2f) / 0.3f;
    if (active) {
        const int r32 = lane & 31, hi = lane >> 5;
        f32x16 acc[2][4];
#pragma unroll
        for (int pt = 0; pt < 2; ++pt)
#pragma unroll
            for (int ct = 0; ct < 4; ++ct) acc[pt][ct] = (f32x16){};
        const float* wcol = W3 + 128 * w + r32 + hi * 512;
#pragma unroll 4
        for (int ks = 0; ks < 32; ++ks) {
            const float a0 = h2[r32][2 * ks + hi], a1 = h2[32 + r32][2 * ks + hi];
            float bw[4];
#pragma unroll
            for (int ct = 0; ct < 4; ++ct) bw[ct] = wcol[(size_t)(2 * ks) * 512 + 32 * ct];
#pragma unroll
            for (int ct = 0; ct < 4; ++ct) { acc[0][ct] = __builtin_amdgcn_mfma_f32_32x32x2f32(a0, bw[ct], acc[0][ct], 0, 0, 0); acc[1][ct] = __builtin_amdgcn_mfma_f32_32x32x2f32(a1, bw[ct], acc[1][ct], 0, 0, 0); }
        }
        float* T = sm + w * 1568;
        const float tinv = 1.0f / (float)(n - 1);
#pragma unroll
        for (int ct = 0; ct < 4; ++ct) {
            const int col = 128 * w + 32 * ct + r32, dir = col >> 8, c = col & 255;
            const float adel = fabsf(dlo + (dhi - dlo) * ((float)c / 255.0f));
            float asum = 0.f;
#pragma unroll
            for (int pt = 0; pt < 2; ++pt) {
#pragma unroll
                for (int r = 0; r < 16; ++r) {
                    const int pl = (r & 3) + 8 * (r >> 2) + 4 * hi, pp = pb * 64 + 32 * pt + pl;
                    float v = acc[pt][ct][r] * __expf(-(float)pp * tinv * adel);
                    if (dir == 1 && pp == 0) v = 0.f;
                    asum += fabsf(v);
                    T[r32 * 33 + pl] = v;
                }
#pragma unroll 4
                for (int i = 0; i < 16; ++i) {
                    const int cc = 2 * i + hi, ocol = 128 * w + 32 * ct + cc, odir = ocol >> 8, oc = ocol & 255;
                    const float v = T[cc * 33 + r32];
                    const int pp = pb * 64 + 32 * pt + r32, lag = odir == 0 ? pp : -pp;
                    if (!(odir == 1 && pp == 0)) {
                        if (isctx) KFC[((size_t)l * 256 + oc) * 512 + lag + CTX] = v; else KF[((size_t)l * 256 + oc) * 16384 + lag + SEQ] = v;
                    }
                }
            }
            asum += __shfl_xor(asum, 32);
            if (hi == 0) atomicAdd(&fnorm[(l * 2 + (isctx ? 1 : 0)) * 256 + c], asum * (1.0f / REP_F));
        }
    }
    __syncthreads();
}

__device__ __forceinline__ void norm_row(const float* __restrict__ hlat, float* __restrict__ hctx, const float* __restrict__ part, int nparts, const float* __restrict__ g, const float* __restrict__ mod, int shift_idx, bf16_t* __restrict__ XN, int row, int lane) {
    const float* src = row < MLAT ? hlat + (size_t)row * D : hctx + (size_t)(row - MLAT) * D;
    const float* m = mod + (size_t)mod_of_row(row) * NMOD * D;
    const float* sh = m + shift_idx * D; const float* sc = m + (shift_idx + 1) * D;
    f32x4 v[4]; float ss = 0.f;
#pragma unroll
    for (int j = 0; j < 4; ++j) v[j] = *(const f32x4*)(src + 256 * j + 4 * lane);
    if (row >= MLAT && nparts > 0) {
        for (int p = 0; p < nparts; ++p) { const float* pp = part + ((size_t)p * MCTX + (row - MLAT)) * D + 4 * lane;
#pragma unroll
            for (int j = 0; j < 4; ++j) v[j] += *(const f32x4*)(pp + 256 * j); }
#pragma unroll
        for (int j = 0; j < 4; ++j) *(f32x4*)(hctx + (size_t)(row - MLAT) * D + 256 * j + 4 * lane) = v[j];
    }
#pragma unroll
    for (int j = 0; j < 4; ++j) ss += v[j].x * v[j].x + v[j].y * v[j].y + v[j].z * v[j].z + v[j].w * v[j].w;
    const float rstd = 1.0f / sqrtf(wave_sum(ss) * (1.f / D) + EPS);
#pragma unroll
    for (int j = 0; j < 4; ++j) {
        const int c0 = 256 * j + 4 * lane;
        const f32x4 gv = *(const f32x4*)(g + c0), sv = *(const f32x4*)(sc + c0), hv = *(const f32x4*)(sh + c0);
        const float aa = v[j].x * rstd * gv.x * (1.f + sv.x) + hv.x, bb = v[j].y * rstd * gv.y * (1.f + sv.y) + hv.y;
        const float cc = v[j].z * rstd * gv.z * (1.f + sv.z) + hv.z, dd = v[j].w * rstd * gv.w * (1.f + sv.w) + hv.w;
        u32x2 o; o.x = pk2(aa, bb); o.y = pk2(cc, dd);
        *(u32x2*)(XN + (size_t)row * D + c0) = o;
    }
}


struct Post2Args { const bf16_t* PX; const float *gqa, *gka, *gqn, *gkn, *convw, *convb, *rope; bf16_t *QA, *KA, *VAT, *NQ, *NK, *NVT, *ZT, *X0T; };
__device__ __forceinline__ void unpack8(const u32x4 p, float (&v)[8]) {
    v[0] = __builtin_bit_cast(float, p.x << 16); v[1] = __builtin_bit_cast(float, p.x & 0xffff0000u); v[2] = __builtin_bit_cast(float, p.y << 16); v[3] = __builtin_bit_cast(float, p.y & 0xffff0000u);
    v[4] = __builtin_bit_cast(float, p.z << 16); v[5] = __builtin_bit_cast(float, p.z & 0xffff0000u); v[6] = __builtin_bit_cast(float, p.w << 16); v[7] = __builtin_bit_cast(float, p.w & 0xffff0000u);
}
__device__ __forceinline__ u32x4 pack8(const float (&v)[8]) { u32x4 o; o.x = pk2(v[0], v[1]); o.y = pk2(v[2], v[3]); o.z = pk2(v[4], v[5]); o.w = pk2(v[6], v[7]); return o; }
__device__ __forceinline__ void headnorm8(float (&v)[8], const float (&g)[8]) {
    float ss = 0.f;
#pragma unroll
    for (int e = 0; e < 8; ++e) ss += v[e] * v[e];
    ss += __shfl_xor(ss, 1); ss += __shfl_xor(ss, 2); ss += __shfl_xor(ss, 4);
    const float rstd = 1.0f / sqrtf(ss * (1.f / 64.f) + EPS);
#pragma unroll
    for (int e = 0; e < 8; ++e) v[e] = v[e] * rstd * g[e];
}
__device__ __forceinline__ void post_unit(const Post2Args& a, int row0, int T, LAS unsigned char* lds3) {
    int tid = threadIdx.x; asm volatile("" : "+v"(tid));
    const int lane = tid & 63, w = __builtin_amdgcn_readfirstlane(tid >> 6), l7 = lane & 7;
    const bool isctx = row0 >= MLAT;
    const int b = isctx ? (row0 - MLAT) / CTX : row0 / SEQ;
    const int tu0 = isctx ? (row0 - MLAT) % CTX : row0 % SEQ;
    const int n = isctx ? CTX : SEQ, kv0 = isctx ? tu0 : CTX + tu0, R = T >> 3;
    constexpr int TP = 516;
    float gq[8], gk[8], gnq[8], gnk[8];
#pragma unroll
    for (int e = 0; e < 8; ++e) { gq[e] = a.gqa[8 * l7 + e]; gk[e] = a.gka[8 * l7 + e]; gnq[e] = a.gqn[8 * l7 + e]; gnk[e] = a.gkn[8 * l7 + e]; }
    const int ch1 = lane >= 32 ? 8 * lane - 256 : 0, ch2 = 256 + 8 * lane;
    float cw1[3][8], cb1[8], cw2[3][8], cb2[8];
#pragma unroll
    for (int e = 0; e < 8; ++e) { cb1[e] = a.convb[ch1 + e]; cb2[e] = a.convb[ch2 + e];
#pragma unroll
        for (int j = 0; j < 3; ++j) { cw1[j][e] = a.convw[j * 768 + ch1 + e]; cw2[j][e] = a.convw[j * 768 + ch2 + e]; } }
    const int pairb = (l7 >> 1) & 1, axis = l7 >> 2, f0 = 8 * (lane & 1);
    for (int i = 0; i < R; ++i) {
        const int tl = w * R + i, t = tu0 + tl, row = row0 + tl;
        const bf16_t* px = a.PX + (size_t)row * INW + 8 * lane;
        const u32x4 z4 = (u32x4){0u, 0u, 0u, 0u};
        const u32x4 p0 = *(const u32x4*)(px), p1 = *(const u32x4*)(px + 512), p2 = *(const u32x4*)(px + 1024), p3 = *(const u32x4*)(px + 1536);
        const u32x4 p4 = lane < 32 ? *(const u32x4*)(px + 2048) : z4;
        const u32x4 a1 = t > 0 ? *(const u32x4*)(px + 512 - INW) : z4, a2 = t > 0 ? *(const u32x4*)(px + 1024 - INW) : z4;
        const u32x4 n1 = t < n - 1 ? *(const u32x4*)(px + 512 + INW) : z4, n2 = t < n - 1 ? *(const u32x4*)(px + 1024 + INW) : z4;
        float cs[8], sn[8];
        { const int pos = axis == 0 ? (t / GRIDW) : (t % GRIDW); const float* rc = a.rope + pos * 16 + f0;
          const f32x4 c0 = *(const f32x4*)rc, c1 = *(const f32x4*)(rc + 4), s0 = *(const f32x4*)(rc + 2048), s1 = *(const f32x4*)(rc + 2052);
#pragma unroll
          for (int e = 0; e < 4; ++e) { cs[e] = c0[e]; cs[4 + e] = c1[e]; sn[e] = s0[e]; sn[4 + e] = s1[e]; } }
        float v[8];
        unpack8(p0, v); headnorm8(v, gq);
        if (!isctx) {
#pragma unroll
            for (int e = 0; e < 8; ++e) { const float o = __shfl_xor(v[e], 2); v[e] = pairb == 0 ? v[e] * cs[e] - o * sn[e] : o * sn[e] + v[e] * cs[e]; } }
#pragma unroll
        for (int e = 0; e < 8; ++e) v[e] *= (0.125f * LOG2E);
        *(u32x4*)(a.QA + (size_t)row * 512 + 8 * lane) = pack8(v);
        unpack8(p1, v); headnorm8(v, gk);
        if (!isctx) {
#pragma unroll
            for (int e = 0; e < 8; ++e) { const float o = __shfl_xor(v[e], 2); v[e] = pairb == 0 ? v[e] * cs[e] - o * sn[e] : o * sn[e] + v[e] * cs[e]; } }
        if (lane < 16) *(u32x4*)(a.KA + ((size_t)b * KVLEN + kv0 + tl) * 128 + 8 * lane) = pack8(v);
        else if (lane < 32) *(u32x4*)(a.VAT + ((size_t)b * KVLEN + kv0 + tl) * 128 + 8 * (lane - 16)) = p1;
        unpack8(p3, v);
        if (lane < 32) { headnorm8(v, gnq);
#pragma unroll
            for (int e = 0; e < 8; ++e) v[e] *= (0.125f * LOG2E);
            *(u32x4*)(a.NQ + (size_t)row * 256 + 8 * lane) = pack8(v); }
        else { headnorm8(v, gnk); *(u32x4*)(a.NK + ((size_t)b * KVLEN + kv0 + tl) * 256 + 8 * (lane - 32)) = pack8(v); }
        float x1v[8], x0v[8], pv[8], cv[8], nv_[8];
        unpack8(a1, pv); unpack8(p1, cv); unpack8(n1, nv_);
#pragma unroll
        for (int e = 0; e < 8; ++e) x0v[e] = cb1[e] + cw1[0][e] * pv[e] + cw1[1][e] * cv[e] + cw1[2][e] * nv_[e];
        unpack8(a2, pv); unpack8(p2, cv); unpack8(n2, nv_);
#pragma unroll
        for (int e = 0; e < 8; ++e) x1v[e] = cb2[e] + cw2[0][e] * pv[e] + cw2[1][e] * cv[e] + cw2[2][e] * nv_[e];
#pragma unroll
        for (int e = 0; e < 8; ++e) { const float o = __shfl_xor(x1v[e], 32); v[e] = lane < 32 ? x1v[e] * o : x0v[e]; }
        { LAS unsigned* dst = (LAS unsigned*)(lds3 + (lane < 32 ? 0 : 64 * TP) + tl * TP + 16 * (lane & 31));
          const u32x4 o = pack8(v); dst[0] = o.x; dst[1] = o.y; dst[2] = o.z; dst[3] = o.w; }
        if (lane < 32) { LAS unsigned* dst = (LAS unsigned*)(lds3 + 128 * TP + tl * TP + 16 * lane); dst[0] = p4.x; dst[1] = p4.y; dst[2] = p4.z; dst[3] = p4.w; }
    }
    __syncthreads();
    {
        const int lpc = T >> 1, cpi = 64 / lpc, cl = lane / lpc, tt = 2 * (lane % lpc);
#pragma unroll
        for (int k = 0; k < 3; ++k) {
            bf16_t* dstb = (k == 0 ? a.ZT : (k == 1 ? a.X0T : a.NVT)) + (size_t)b * 256 * KVLEN + kv0 + tt;
            const LAS unsigned char* tile = lds3 + k * 64 * TP + tt * TP;
            for (int c0 = w * 32; c0 < w * 32 + 32; c0 += cpi) { const int c = c0 + cl;
                const unsigned lo = *(const LAS unsigned short*)(tile + 2 * c), hi = *(const LAS unsigned short*)(tile + TP + 2 * c);
                *(unsigned*)(dstb + (size_t)c * KVLEN) = lo | (hi << 16); }
        }
    }
    __syncthreads();
}

constexpr int NA_RPB_OFF = 122880;
__device__ __forceinline__ void na_compute(const bf16x8 (&kf)[4], const bf16x8 (&vf)[4], const bf16x8 (&qf)[2], f32x4 (&o)[4], float& mrun, float& lrun, int g, bool win, int kc0, int cs, const LAS float* rprow) {
    f32x4 sA = (f32x4){0.f, 0.f, 0.f, 0.f}, sB = sA;
#pragma unroll
    for (int ks = 0; ks < 2; ++ks) {
        sA = __builtin_amdgcn_mfma_f32_16x16x32_bf16(kf[2 * ks], qf[ks], sA, 0, 0, 0);
        sB = __builtin_amdgcn_mfma_f32_16x16x32_bf16(kf[2 * ks + 1], qf[ks], sB, 0, 0, 0);
    }
    if (win) {
#pragma unroll
        for (int r = 0; r < 4; ++r) {
            const int kca = kc0 + 8 * g + r, kcb = kca + 4;
            sA[r] = (kca >= cs && kca < cs + 16) ? sA[r] + rprow[kca] : -INFINITY;
            sB[r] = (kcb >= cs && kcb < cs + 16) ? sB[r] + rprow[kcb] : -INFINITY;
        }
    }
    float mx = fmaxf(fmaxf(fmaxf(sA.x, sA.y), fmaxf(sA.z, sA.w)), fmaxf(fmaxf(sB.x, sB.y), fmaxf(sB.z, sB.w)));
    mx = fmaxf(mx, __shfl_xor(mx, 16)); mx = fmaxf(mx, __shfl_xor(mx, 32));
    const float mnew = fmaxf(mrun, mx), alpha = __builtin_amdgcn_exp2f(mrun - mnew);
    mrun = mnew;
    float p[8];
    p[0] = __builtin_amdgcn_exp2f(sA.x - mnew); p[1] = __builtin_amdgcn_exp2f(sA.y - mnew); p[2] = __builtin_amdgcn_exp2f(sA.z - mnew); p[3] = __builtin_amdgcn_exp2f(sA.w - mnew);
    p[4] = __builtin_amdgcn_exp2f(sB.x - mnew); p[5] = __builtin_amdgcn_exp2f(sB.y - mnew); p[6] = __builtin_amdgcn_exp2f(sB.z - mnew); p[7] = __builtin_amdgcn_exp2f(sB.w - mnew);
    lrun = lrun * alpha + ((p[0] + p[1]) + (p[2] + p[3])) + ((p[4] + p[5]) + (p[6] + p[7]));
    u32x4 pw; pw.x = pk2(p[0], p[1]); pw.y = pk2(p[2], p[3]); pw.z = pk2(p[4], p[5]); pw.w = pk2(p[6], p[7]);
    const bf16x8 pf = __builtin_bit_cast(bf16x8, pw);
#pragma unroll
    for (int dt = 0; dt < 4; ++dt) { o[dt] = o[dt] * alpha; o[dt] = __builtin_amdgcn_mfma_f32_16x16x32_bf16(vf[dt], pf, o[dt], 0, 0, 0); }
}
__device__ __forceinline__ void na_wave2(const bf16_t* __restrict__ NQ, const bf16_t* __restrict__ NK, const bf16_t* __restrict__ NVT, const LAS float* rp, bf16_t* __restrict__ Y, int row0, int h, int lane) {
    const int fr = lane & 15, g = lane >> 4;
    const bool isctx = row0 >= MLAT;
    const int b = isctx ? (row0 - MLAT) / CTX : row0 / SEQ;
    const int t0 = isctx ? (row0 - MLAT) % CTX : row0 % SEQ;
    const int r = t0 / GRIDW, q0 = t0 % GRIDW, qc = q0 + fr;
    const int rs = min(max(r - 4, 0), SEQ / GRIDW - 8), cs = min(max(qc - 8, 0), GRIDW - 16);
    bf16x8 qf[2];
#pragma unroll
    for (int ks = 0; ks < 2; ++ks) qf[ks] = *(const bf16x8*)(NQ + (size_t)(row0 + fr) * 256 + h * 64 + 32 * ks + 8 * g);
    const int keyA = 8 * (fr >> 2) + (fr & 3);
    const bf16_t* Kb = NK + (size_t)b * KVLEN * 256 + h * 64 + 8 * g + (size_t)keyA * 256;
    const bf16_t* Vb = NVT + ((size_t)b * 4 + h) * 64 * KVLEN + 8 * g + (size_t)fr * KVLEN;
    f32x4 o[4];
#pragma unroll
    for (int i = 0; i < 4; ++i) o[i] = (f32x4){0.f, 0.f, 0.f, 0.f};
    float mrun = -INFINITY, lrun = 0.f;
    const int kb_lo = q0 >= 48 ? 1 : 0, two = (q0 == 16 || q0 == 32) ? 1 : 0;
    const int nblk = isctx ? 8 : 8 + (8 << two);
#define NA_INFO(j, key0, kc0, roff) do { if ((j) < 8) { key0 = 32 * (j); kc0 = 0; roff = 0; } else { const int jj_ = (j) - 8, i_ = jj_ >> two, kb_ = kb_lo + (jj_ & two); \
        key0 = CTX + (rs + i_) * GRIDW + 32 * kb_; kc0 = 32 * kb_; roff = (h * 15 + (rs + i_ - r + 7)) * 31 + 15 - qc; } } while (0)
#define NA_LOAD(key0, kf, vf) do { const bf16_t* kp_ = Kb + (size_t)(key0) * 256; kf[0] = *(const bf16x8*)(kp_); kf[1] = *(const bf16x8*)(kp_ + 4 * 256); kf[2] = *(const bf16x8*)(kp_ + 32); kf[3] = *(const bf16x8*)(kp_ + 4 * 256 + 32); \
        _Pragma("unroll") for (int dt_ = 0; dt_ < 4; ++dt_) vf[dt_] = *(const bf16x8*)(Vb + (size_t)(16 * dt_) * KVLEN + (key0)); } while (0)
    bf16x8 kf0[4], vf0[4], kf1[4], vf1[4];
    int key0a, kc0a, roffa, key0b, kc0b, roffb;
    NA_INFO(0, key0a, kc0a, roffa); NA_LOAD(key0a, kf0, vf0);
    for (int j = 0; j < nblk; j += 2) {
        NA_INFO(j + 1, key0b, kc0b, roffb); NA_LOAD(key0b, kf1, vf1);
        na_compute(kf0, vf0, qf, o, mrun, lrun, g, j >= 8, kc0a, cs, rp + roffa);
        { const int jn = min(j + 2, nblk - 1); NA_INFO(jn, key0a, kc0a, roffa); NA_LOAD(key0a, kf0, vf0); }
        na_compute(kf1, vf1, qf, o, mrun, lrun, g, j + 1 >= 8, kc0b, cs, rp + roffb);
    }
#undef NA_INFO
#undef NA_LOAD
    lrun += __shfl_xor(lrun, 16); lrun += __shfl_xor(lrun, 32);
    const float il = 1.0f / lrun;
#pragma unroll
    for (int dt = 0; dt < 4; ++dt) { u32x2 ov; ov.x = pk2(o[dt].x * il, o[dt].y * il); ov.y = pk2(o[dt].z * il, o[dt].w * il);
        *(u32x2*)(Y + (size_t)(row0 + fr) * D + 768 + h * 64 + 16 * dt + 4 * g) = ov; }
}


__device__ __forceinline__ void na_pair(const bf16_t* __restrict__ NQ, const bf16_t* __restrict__ NK, const bf16_t* __restrict__ NVT, const LAS float* rp, bf16_t* __restrict__ Y, int b, int h, int p, int lane) {
    const int fr = lane & 15, g = lane >> 4;
    const bool isctx = p >= 256;
    const int r = isctx ? 0 : (p >> 1), type = isctx ? 1 : (p & 1);
    const int q0A = type ? 32 : 0, q0B = type ? 48 : 16;
    const int rowA = isctx ? MLAT + b * CTX + (p - 256) * 32 : b * SEQ + r * GRIDW + q0A;
    const int rowB = isctx ? rowA + 16 : b * SEQ + r * GRIDW + q0B;
    const int qcA = q0A + fr, qcB = q0B + fr;
    const int rs = min(max(r - 4, 0), SEQ / GRIDW - 8), csA = min(max(qcA - 8, 0), GRIDW - 16), csB = min(max(qcB - 8, 0), GRIDW - 16);
    bf16x8 qfA[2], qfB[2];
#pragma unroll
    for (int ks = 0; ks < 2; ++ks) { qfA[ks] = *(const bf16x8*)(NQ + (size_t)(rowA + fr) * 256 + h * 64 + 32 * ks + 8 * g); qfB[ks] = *(const bf16x8*)(NQ + (size_t)(rowB + fr) * 256 + h * 64 + 32 * ks + 8 * g); }
    const int keyA = 8 * (fr >> 2) + (fr & 3);
    const bf16_t* Kb = NK + (size_t)b * KVLEN * 256 + h * 64 + 8 * g + (size_t)keyA * 256;
    const bf16_t* Vb = NVT + ((size_t)b * 4 + h) * 64 * KVLEN + 8 * g + (size_t)fr * KVLEN;
    f32x4 oA[4], oB[4];
#pragma unroll
    for (int i = 0; i < 4; ++i) { oA[i] = (f32x4){0.f, 0.f, 0.f, 0.f}; oB[i] = oA[i]; }
    float mA = -INFINITY, lA = 0.f, mB = -INFINITY, lB = 0.f;
    const int nit = isctx ? 4 : 12;
#define NP_KEY(it, y) ((it) < 4 ? 64 * (it) + 32 * (y) : CTX + (rs + (it) - 4) * GRIDW + 32 * (y))
#define NA_LOAD(key0, kf, vf) do { const bf16_t* kp_ = Kb + (size_t)(key0) * 256; kf[0] = *(const bf16x8*)(kp_); kf[1] = *(const bf16x8*)(kp_ + 4 * 256); kf[2] = *(const bf16x8*)(kp_ + 32); kf[3] = *(const bf16x8*)(kp_ + 4 * 256 + 32); \
        _Pragma("unroll") for (int dt_ = 0; dt_ < 4; ++dt_) vf[dt_] = *(const bf16x8*)(Vb + (size_t)(16 * dt_) * KVLEN + (key0)); } while (0)
    bf16x8 kf0[4], vf0[4], kf1[4], vf1[4];
    NA_LOAD(NP_KEY(0, 0), kf0, vf0);
    for (int it = 0; it < nit; ++it) {
        NA_LOAD(NP_KEY(it, 1), kf1, vf1);
        const bool win = it >= 4, bx_ = !win || type == 0, ay_ = !win || type != 0;
        const int rrow = (h * 15 + (rs + it - 4 - r + 7)) * 31 + 15;
        const LAS float* rpA = rp + (win ? rrow - qcA : 0); const LAS float* rpB = rp + (win ? rrow - qcB : 0);
        na_compute(kf0, vf0, qfA, oA, mA, lA, g, win, 0, csA, rpA);
        if (bx_) na_compute(kf0, vf0, qfB, oB, mB, lB, g, win, 0, csB, rpB);
        { const int itn = min(it + 1, nit - 1); NA_LOAD(NP_KEY(itn, 0), kf0, vf0); }
        if (ay_) na_compute(kf1, vf1, qfA, oA, mA, lA, g, win, 32, csA, rpA);
        na_compute(kf1, vf1, qfB, oB, mB, lB, g, win, 32, csB, rpB);
    }
#undef NP_KEY
#undef NA_LOAD
    lA += __shfl_xor(lA, 16); lA += __shfl_xor(lA, 32); lB += __shfl_xor(lB, 16); lB += __shfl_xor(lB, 32);
    const float ilA = 1.0f / lA, ilB = 1.0f / lB;
#pragma unroll
    for (int dt = 0; dt < 4; ++dt) { u32x2 ov; ov.x = pk2(oA[dt].x * ilA, oA[dt].y * ilA); ov.y = pk2(oA[dt].z * ilA, oA[dt].w * ilA);
        *(u32x2*)(Y + (size_t)(rowA + fr) * D + 768 + h * 64 + 16 * dt + 4 * g) = ov;
        ov.x = pk2(oB[dt].x * ilB, oB[dt].y * ilB); ov.y = pk2(oB[dt].z * ilB, oB[dt].w * ilB);
        *(u32x2*)(Y + (size_t)(rowB + fr) * D + 768 + h * 64 + 16 * dt + 4 * g) = ov; }
}

constexpr int HY_POFF = 8208, HY_PSZ = 16416, HY_ZBLK = 72, HY_ZLEN = 160 * HY_ZBLK;
constexpr int HY_LDS = HY_PSZ * 4 + 2 * HY_ZLEN * 2;
__device__ __forceinline__ int crow32(int r, int hi) { return (r & 3) + 8 * (r >> 2) + 4 * hi; }
__device__ __forceinline__ void hyena_mfma_unit(const bf16_t* __restrict__ ZT  , const float* __restrict__ kf  , float inorm, float sk,
                                                const bf16_t* __restrict__ X0T, bf16_t* __restrict__ Y, int c, LAS unsigned char* lds3) {
    int tid = threadIdx.x; asm volatile("" : "+v"(tid));
    const int lane = tid & 63, w = __builtin_amdgcn_readfirstlane(tid >> 6), r32 = lane & 31, hi = lane >> 5;
    LAS unsigned* P = (LAS unsigned*)lds3; LAS bf16_t* ZP = (LAS bf16_t*)(lds3 + HY_PSZ * 4);
    for (int g8 = tid; g8 < HY_PSZ / 8; g8 += NTHREADS) {
        const int w0 = 8 * g8 - HY_POFF;
        float tv[9];
#pragma unroll
        for (int j = 0; j < 9; ++j) { const int ww = w0 - 1 + j; tv[j] = (ww >= -(SEQ - 1) && ww <= SEQ - 1) ? kf[ww + SEQ] : 0.f; }
        u32x4 lo, hi4;
        hi4.w = pk2(tv[1], tv[0]); hi4.z = pk2(tv[2], tv[1]); hi4.y = pk2(tv[3], tv[2]); hi4.x = pk2(tv[4], tv[3]);
        lo.w = pk2(tv[5], tv[4]); lo.z = pk2(tv[6], tv[5]); lo.y = pk2(tv[7], tv[6]); lo.x = pk2(tv[8], tv[7]);
        *(LAS u32x4*)(P + HY_PSZ - 8 - 8 * g8) = lo; *(LAS u32x4*)(P + HY_PSZ - 4 - 8 * g8) = hi4;
    }
    for (int idx = tid; idx < 2 * (SEQ / 8); idx += NTHREADS) { const int bb = idx / (SEQ / 8), e8 = (idx % (SEQ / 8)) * 8;
        *(LAS u32x4*)(ZP + bb * HY_ZLEN + (16 + (e8 >> 6)) * HY_ZBLK + (e8 & 63)) = *(const u32x4*)(ZT + ((size_t)bb * 256 + c) * KVLEN + CTX + e8); }
    for (int idx = tid; idx < 4 * 16 * 8; idx += NTHREADS) { const int q = idx >> 7, blk = (idx >> 3) & 15, e8 = (idx & 7) * 8;
        *(LAS u32x4*)(ZP + (q >> 1) * HY_ZLEN + (((q & 1) ? 144 : 0) + blk) * HY_ZBLK + e8) = (u32x4){0u, 0u, 0u, 0u}; }
    __syncthreads();
    f32x16 acc0 = {}, acc1 = {};
    const int b = r32 >> 4, tb = 16 * w + (r32 & 15);
    const LAS bf16_t* zlane = ZP + b * HY_ZLEN + (16 + tb) * HY_ZBLK + 8 * hi;
    const LAS unsigned* plane = P + (HY_PSZ - 1 - HY_POFF) - r32 + 8 * hi;
    const int dlo = 16 * w - 127, dhi = 16 * w + 15;
#define HY_AFR(A, e, d) do { const LAS unsigned* pp_ = plane - 64 * (d) - 16 * ((e) - 3); A[e].x = pp_[0]; A[e].y = pp_[2]; A[e].z = pp_[4]; A[e].w = pp_[6]; } while (0)
#define HY_LOAD(A, B, d) do { _Pragma("unroll") for (int ks_ = 0; ks_ < 4; ++ks_) B[ks_] = *(const LAS bf16x8*)(zlane - HY_ZBLK * (d) + 16 * ks_); HY_AFR(A, 2, d); HY_AFR(A, 3, d); HY_AFR(A, 4, d); HY_AFR(A, 5, d); } while (0)
#define HY_MMA(A, B) do { _Pragma("unroll") for (int ks_ = 0; ks_ < 4; ++ks_) { \
        acc0 = __builtin_amdgcn_mfma_f32_32x32x16_bf16(__builtin_bit_cast(bf16x8, A[3 - ks_]), B[ks_], acc0, 0, 0, 0); \
        acc1 = __builtin_amdgcn_mfma_f32_32x32x16_bf16(__builtin_bit_cast(bf16x8, A[5 - ks_]), B[ks_], acc1, 0, 0, 0); } } while (0)
    u32x4 AX[6], AY[6]; bf16x8 BX[4], BY[4];
    HY_AFR(AX, 0, dlo); HY_AFR(AX, 1, dlo); HY_LOAD(AX, BX, dlo);
    for (int d = dlo; d + 1 <= dhi; d += 2) {
        AY[0] = AX[4]; AY[1] = AX[5]; HY_LOAD(AY, BY, d + 1);
        HY_MMA(AX, BX);
        AX[0] = AY[4]; AX[1] = AY[5]; HY_LOAD(AX, BX, d + 2);
        HY_MMA(AY, BY);
    }
    HY_MMA(AX, BX);
#undef HY_AFR
#undef HY_LOAD
#undef HY_MMA
    __syncthreads();
    LAS bf16_t* XL = (LAS bf16_t*)lds3;
    for (int idx = tid; idx < 2 * (SEQ / 8); idx += NTHREADS) { const int bb = idx / (SEQ / 8), e8 = (idx % (SEQ / 8)) * 8;
        *(LAS u32x4*)(XL + bb * SEQ + e8) = *(const u32x4*)(X0T + ((size_t)bb * 256 + c) * KVLEN + CTX + e8); }
    __syncthreads();
#pragma unroll
    for (int i0 = 0; i0 < 2; ++i0)
#pragma unroll
        for (int r = 0; r < 16; ++r) {
            const int t = 64 * tb + 32 * i0 + crow32(r, hi); const size_t row = (size_t)b * SEQ + t;
            const float zv = bf2f(ZP[b * HY_ZLEN + (16 + (t >> 6)) * HY_ZBLK + (t & 63)]);
            const float y = (i0 == 0 ? acc0[r] : acc1[r]) * inorm + zv * sk;
            Y[row * D + 512 + c] = (bf16_t)f2bf(y * bf2f(XL[b * SEQ + t]));
        }
    __syncthreads();
}

__device__ __forceinline__ void hyena_ctx_item(const bf16_t* __restrict__ ZT, const float* __restrict__ KFC, const float* __restrict__ fnorm, const float* __restrict__ skip, const bf16_t* __restrict__ X0T, bf16_t* __restrict__ Y, int item, int t) {
    const int c = item & 255, b = item >> 8;
    const bf16_t* zp = ZT + ((size_t)b * 256 + c) * KVLEN; const float* kf = KFC + (size_t)c * 512;
    float acc = 0.f;
    for (int s = 0; s < CTX; ++s) acc += kf[t - s + CTX] * bf2f(zp[s]);
    const size_t row = (size_t)MLAT + b * CTX + t;
    const float y = acc / fnorm[c] + bf2f(zp[t]) * skip[c];
    Y[row * D + 512 + c] = (bf16_t)f2bf(y * bf2f(X0T[((size_t)b * 256 + c) * KVLEN + t]));
}

#define XB_TMO      128
#define XB_XCNT(j)  (256  + 64 * (j))
#define XB_XSUB(j)  (1280 + 64 * (j))
#define XB_XGEN(j)  (2304 + 64 * (j))
#define XB_TOP      3328
#define XB_TOPGEN   3392
#define XCD_BAR_WORDS 3456
#define XB_SPIN_CAP (1u << 18)

__device__ __forceinline__ unsigned xb_ld(unsigned* p)              { return __hip_atomic_load(p, __ATOMIC_RELAXED, __HIP_MEMORY_SCOPE_AGENT); }
__device__ __forceinline__ unsigned xb_add(unsigned* p, unsigned v) { return __hip_atomic_fetch_add(p, v, __ATOMIC_RELAXED, __HIP_MEMORY_SCOPE_AGENT); }
__device__ __forceinline__ unsigned xb_xcc_id() { return (unsigned)__builtin_amdgcn_s_getreg((3 << 11) | 20) & 0xFu; }
#define XB_SPIN(cond, bar) do { unsigned _sp = 0; while (cond) { __builtin_amdgcn_s_sleep(1); \
    if ((++_sp & 255u) == 0u) { if (xb_ld(&(bar)[XB_TMO])) break; if (_sp > XB_SPIN_CAP) { atomicAdd(&(bar)[XB_TMO], 1u); break; } } } } while (0)

struct XcdBarrier {
    unsigned* bar; unsigned x;
    volatile LAS unsigned* st;
};

__device__ __forceinline__ XcdBarrier xcd_barrier_post(unsigned* bar, volatile LAS unsigned* st) {
    XcdBarrier b; b.bar = bar; b.x = xb_xcc_id(); b.st = st;
    if (threadIdx.x == 0) (void)xb_add(&bar[XB_XCNT(b.x)], 1u);
    return b;
}
__device__ __forceinline__ void xcd_barrier_complete(unsigned* bar, unsigned x, unsigned& nloc, unsigned& nx) {
    const unsigned G = gridDim.x * gridDim.y * gridDim.z;
    unsigned sum, cnt, mine, sp = 0u;
    for (;;) {
        sum = 0u; cnt = 0u; mine = 0u;
#pragma unroll
        for (unsigned j = 0; j < 16; ++j) { const unsigned c = xb_ld(&bar[XB_XCNT(j)]); sum += c; cnt += (c > 0u) ? 1u : 0u; mine = (j == x) ? c : mine; }
        if (sum == G) break;
        __builtin_amdgcn_s_sleep(1);
        if ((++sp & 255u) == 0u) { if (xb_ld(&bar[XB_TMO])) break; if (sp > XB_SPIN_CAP) { atomicAdd(&bar[XB_TMO], 1u); break; } }
    }
    nloc = mine > 0u ? mine : 1u; nx = cnt > 0u ? cnt : 1u;
}

__device__ __forceinline__ void xcd_barrier(const XcdBarrier& b) {
    asm volatile("s_waitcnt vmcnt(0)" ::: "memory");
    __syncthreads();
    if (threadIdx.x == 0) {
        unsigned* bar = b.bar;
        __builtin_amdgcn_s_waitcnt(0);
        unsigned nloc = b.st[0], nx = b.st[1];
        if (nloc == 0u) { xcd_barrier_complete(bar, b.x, nloc, nx); b.st[0] = nloc; b.st[1] = nx; }
        const unsigned old = xb_add(&bar[XB_XSUB(b.x)], 1u);
        const unsigned gen = old / nloc;
        if (old + 1u == (gen + 1u) * nloc) {
            __builtin_amdgcn_fence(__ATOMIC_RELEASE, "agent");
            asm volatile("s_waitcnt vmcnt(0)" ::: "memory");
            const unsigned og = xb_add(&bar[XB_TOP], 1u);
            const unsigned tg = og / nx;
            if (og + 1u == (tg + 1u) * nx) xb_add(&bar[XB_TOPGEN], 1u);
            else XB_SPIN(xb_ld(&bar[XB_TOPGEN]) == tg, bar);
            __builtin_amdgcn_fence(__ATOMIC_ACQUIRE, "agent");
            xb_add(&bar[XB_XGEN(b.x)], 1u);
            asm volatile("s_waitcnt vmcnt(0)" ::: "memory");
        } else {
            XB_SPIN(xb_ld(&bar[XB_XGEN(b.x)]) == gen, bar);
            __builtin_amdgcn_fence(__ATOMIC_ACQUIRE, "agent");
            asm volatile("s_waitcnt vmcnt(0)" ::: "memory");
        }
    }
    __syncthreads();
}

__global__ void __launch_bounds__(NTHREADS, 2) mega_fwd(MegaArgs a) {
    extern __shared__ __attribute__((aligned(16))) unsigned char lds[];
    cg::grid_group grid = cg::this_grid();
    const int tid0 = threadIdx.x, wave = __builtin_amdgcn_readfirstlane(tid0 >> 6), half = __builtin_amdgcn_readfirstlane(tid0 >> 8);
#define PHASE_TID() int tid = threadIdx.x; asm volatile("" : "+v"(tid)); const int lane = tid & 63, t256 = tid & 255; (void)lane; (void)t256
    const int G = gridDim.x, bx = blockIdx.x;
    const int gw = bx * NWAVES + wave, ngw = G * NWAVES;
    const int vb = bx * 2 + half, nvb = G * 2;
    unsigned char* ws = a.ws;
    float* hlat = a.out; float* hctx = (float*)(ws + WS_HCTX);
    float* mod = (float*)(ws + WS_MOD); float* fnorm = (float*)(ws + WS_FNORM);
    bf16_t* XN = (bf16_t*)(ws + WS_XN); bf16_t* HID = (bf16_t*)(ws + WS_HID); bf16_t* PX = (bf16_t*)(ws + WS_PX);
    bf16_t* QA = (bf16_t*)(ws + WS_QA); bf16_t* KA = (bf16_t*)(ws + WS_KA); bf16_t* VAT = (bf16_t*)(ws + WS_VAT);
    bf16_t* NQ = (bf16_t*)(ws + WS_NQ); bf16_t* NK = (bf16_t*)(ws + WS_NK); bf16_t* NV = (bf16_t*)(ws + WS_NV);
    bf16_t* ZT = (bf16_t*)(ws + WS_Z); float* ROPE = (float*)(ws + WS_ZC); bf16_t* X0T = (bf16_t*)(ws + WS_X0);
    bf16_t* YMIX = (bf16_t*)(ws + WS_YMIX); float* KF = (float*)(ws + WS_KF); float* KFC = (float*)(ws + WS_KFC); float* PART = (float*)(ws + WS_PART);
    LAS unsigned char* lds3 = (LAS unsigned char*)lds;
    volatile LAS unsigned* bst = (volatile LAS unsigned*)(lds3 + 131072);
    for (size_t i = (size_t)bx * NTHREADS + threadIdx.x; i < (1 * MiB) / 16; i += (size_t)G * NTHREADS) ((u32x4*)(ws + WS_CTL))[i] = (u32x4){0u, 0u, 0u, 0u};
    if (threadIdx.x < 2) bst[threadIdx.x] = 0u;
    grid.sync();
    const XcdBarrier xbar = xcd_barrier_post((unsigned*)(ws + WS_BAR), bst);

    {
        PHASE_TID();
        for (int rp_ = 0; rp_ < REP_F; ++rp_) for (int it0 = bx * 2; it0 < DEPTH * 132; it0 += nvb) { const int it = it0 + half; p0_filter_item(a, (float*)(lds + half * 41728), (float*)(lds + 83456 + wave * 4096), it, it < DEPTH * 132, t256); }
        __syncthreads();
        float* sc = (float*)(lds + 69632);
        const float* c = a.in[1]; const float* cctx = a.in[3];
        for (int i = tid; i < D; i += NTHREADS) { sc[i] = silu_f(c[i]); sc[D + i] = silu_f(c[D + i]); sc[2 * D + i] = silu_f(cctx[i]); }
        __syncthreads();
        for (int i = bx * NTHREADS + tid; i < 128 * 16; i += G * NTHREADS) { const int pos = i >> 4, f = i & 15;
            const float inv = exp2f(-(float)f * (13.287712379549449f / 16.0f)); float rev = (float)pos * inv * 0.15915494309189535f; rev = rev - floorf(rev);
            ROPE[i] = __builtin_amdgcn_cosf(rev); ROPE[2048 + i] = __builtin_amdgcn_sinf(rev); }
        const f32x4* xs = (const f32x4*)a.in[0]; f32x4* xd = (f32x4*)hlat;
        for (size_t i = (size_t)bx * NTHREADS + tid; i < (size_t)MLAT * D / 4; i += (size_t)G * NTHREADS) xd[i] = xs[i];
        const f32x4* cs = (const f32x4*)a.in[2]; f32x4* cd = (f32x4*)hctx;
        for (size_t i = (size_t)bx * NTHREADS + tid; i < (size_t)MCTX * D / 4; i += (size_t)G * NTHREADS) cd[i] = cs[i];
        {
            constexpr int NA_ITEMS = DEPTH * (NMOD * D / 256) * 16;
            constexpr int NW_ITEMS = DEPTH * (4 * ((D / 64) * (FF / 32)) + 2 * ((FF / 64) * (D / 32)) + (D / 64) * (INW / 32) + (D / 64) * (D / 32));
            unsigned* qctr = (unsigned*)(ws + WS_QCTR);
            for (;;) {
                unsigned qb = 0; if (lane == 0) qb = atomicAdd(qctr, 4u);
                const int base = (int)__builtin_amdgcn_readfirstlane(qb);
                if (base >= NA_ITEMS + NW_ITEMS) break;
                const int hi = min(base + 4, NA_ITEMS + NW_ITEMS);
                if (base < NA_ITEMS) p0_adaln(a, sc, base, min(hi, NA_ITEMS), lane);
                if (hi > NA_ITEMS) p0_weights(a, lds, max(base, NA_ITEMS) - NA_ITEMS, hi - NA_ITEMS, wave, lane);
            }
        }
    }
    GRID_SYNC();

    for (int l = 0; l < DEPTH; ++l) {
        const float* modl = mod + (size_t)l * 3 * NMOD * D;
        const bool last = (l == DEPTH - 1);
        for (int f = 0; f < 2; ++f) {
            if (f == 1) {
                { PHASE_TID(); for (int rp_ = 0; rp_ < REP_NORM; ++rp_) for (int row = gw; row < MTOT; row += ngw) norm_row(hlat, hctx, PART, 11, a.in[10] + l * D, modl, 3, XN, row, lane); }
                GRID_SYNC();
                { pg8::Gemm g{XN, (const bf16_t*)(ws + WS_WIN) + (size_t)l * INW * D, MTOT, INW, D, D}; pg8::StaticOrder S; S.init(MTOT, INW, G, bx);
                  pg8::EpiBf16 E{PX, INW};
                  for (int rp_ = 0; rp_ < REP_IN; ++rp_) pg8::gemm_phase<pg8::EpiBf16, pg8::StaticOrder, true, true>(lds3, g, S, E); }
                GRID_SYNC();
                { Post2Args pa; pa.PX = PX; pa.gqa = a.in[13] + l * 64; pa.gka = a.in[14] + l * 64; pa.gqn = a.in[24] + l * 64; pa.gkn = a.in[25] + l * 64; pa.convw = a.in[15] + (size_t)l * 3 * 768; pa.convb = a.in[16] + l * 768; pa.rope = ROPE;
                  pa.QA = QA; pa.KA = KA; pa.VAT = VAT; pa.NQ = NQ; pa.NK = NK; pa.NVT = NV; pa.ZT = ZT; pa.X0T = X0T;
                  for (int rp_ = 0; rp_ < REP_POST; ++rp_)
                  for (int u = bx; u < MLAT / 64; u += G) post_unit(pa, u * 64, 64, lds3);
                  for (int u = bx; u < MCTX / 16; u += G) post_unit(pa, MLAT + u * 16, 16, lds3); }
                GRID_SYNC();
                {
                    PHASE_TID();
                    const float* rpbl = a.in[26] + (size_t)l * 4 * 15 * 31;
                    LAS float* rp = (LAS float*)(lds3 + NA_RPB_OFF);
                    for (int i = tid; i < 4 * 15 * 31; i += NTHREADS) rp[i] = rpbl[i] * LOG2E;
                    __syncthreads();
                    for (int rp_ = 0; rp_ < REP_HY; ++rp_)
                    for (int c = bx; c < 256; c += G) { const float* fnl = fnorm + (l * 2 + 0) * 256;
                        hyena_mfma_unit(ZT, KF + ((size_t)l * 256 + c) * 16384, 1.0f / fnl[c], a.in[23][l * 256 + c], X0T, YMIX, c, lds3); }
                    {
                        const int grp = (bx & 7) >> 1, jl = (bx >> 3) * 2 + (bx & 1);
                        const int gb = grp >> 1, gk = grp & 1;
                        if (G == 256) {
                        for (int i = 0; i < 2 * REP_GQA; ++i) { const int u = jl + 64 * (i & 1), hh = u >> 5, qb = u & 31;
                            attn_body::attn_unit<8>((long)gb * SEQ + qb * 256, gk * 4 + hh, (long)gb * KVLEN, KVLEN, (const attn_body::bf16*)QA, (const attn_body::bf16*)KA, (const attn_body::bf16*)VAT, (attn_body::bf16*)YMIX, (char*)lds); }
                        } else {
                        for (int u = bx; u < 512; u += G) { const int ub = u >> 8, uh = (u >> 5) & 7, qb = u & 31;
                            attn_body::attn_unit<8>((long)ub * SEQ + qb * 256, uh, (long)ub * KVLEN, KVLEN, (const attn_body::bf16*)QA, (const attn_body::bf16*)KA, (const attn_body::bf16*)VAT, (attn_body::bf16*)YMIX, (char*)lds); }
                        }
                        if (!last) for (int cu = bx; cu < 16; cu += G) attn_body::attn_unit<8>((long)MLAT + (cu >> 3) * CTX, cu & 7, (long)(cu >> 3) * KVLEN, CTX, (const attn_body::bf16*)QA, (const attn_body::bf16*)KA, (const attn_body::bf16*)VAT, (attn_body::bf16*)YMIX, (char*)lds);
                        __syncthreads();
                    }
                    const int n_na = (last ? MLAT : MTOT) / 16 * 4;
                    for (int rp_ = 0; rp_ < REP_NA; ++rp_) {
                    if (G == 256) {
                        const int xb = (bx & 7) >> 2, xh = bx & 3, lw = (bx >> 3) * NWAVES + wave, nqi = SEQ / 16 + (last ? 0 : CTX / 16);
                        (void)nqi; na_pair(NQ, NK, NV, rp, YMIX, xb, xh, lw, lane);
                        if (!last && (lw & 31) == 0) na_pair(NQ, NK, NV, rp, YMIX, xb, xh, 256 + (lw >> 5), lane);
                    } else {
                        (void)n_na; const int npp = 256 + (last ? 0 : 8); for (int it = gw; it < 8 * npp; it += ngw) na_pair(NQ, NK, NV, rp, YMIX, (it / npp) >> 2, (it / npp) & 3, it % npp, lane);
                    } }
                    if (!last) for (int rp_ = 0; rp_ < REP_HYC; ++rp_) for (int it = vb; it < 512; it += nvb) hyena_ctx_item(ZT, KFC + (size_t)l * 256 * 512, fnorm + (l * 2 + 1) * 256, a.in[23] + l * 256, X0T, YMIX, it, t256);
                }
                GRID_SYNC();
                { pg8::Gemm g{YMIX, (const bf16_t*)(ws + WS_WOUT) + (size_t)l * D * D, MLAT, D, D, D}; pg8::StaticOrder S; S.init(MLAT, D, G, bx);
                  pg8::EpiRes E{hlat, hctx, modl, 5, 1.0f / REP_OUT};
                  for (int rp_ = 0; rp_ < REP_OUT; ++rp_) pg8::gemm_phase<pg8::EpiRes, pg8::StaticOrder, true, true>(lds3, g, S, E);
                  if (!last) { pg8::Gemm g2{YMIX, (const bf16_t*)(ws + WS_WOUT) + (size_t)l * D * D, MTOT, D, 256, D}; pg8::SplitKOrder S2{8 * 4, G, (bx + 64) % G, 4, 4, 64};
                    pg8::EpiResPart E2{PART, modl, 5, 1.0f};
                    for (int rp_ = 0; rp_ < REP_SK; ++rp_) pg8::gemm_phase<pg8::EpiResPart, pg8::SplitKOrder, false, true>(lds3, g2, S2, E2); } }
                GRID_SYNC();
            }
            const int Mf = (last && f == 1) ? MLAT : MTOT;
            { PHASE_TID(); for (int rp_ = 0; rp_ < REP_NORM; ++rp_) for (int row = gw; row < Mf; row += ngw) norm_row(hlat, hctx, PART, f == 0 ? (l > 0 ? 11 : 0) : 4, (f == 0 ? a.in[6] : a.in[27]) + l * D, modl, f == 0 ? 0 : 6, XN, row, lane); }
            GRID_SYNC();
            { pg8::Gemm g{XN, (const bf16_t*)(ws + WS_WGU) + (size_t)(l * 2 + f) * 2 * FF * D, Mf, 2 * FF, D, D}; pg8::StaticOrder S; S.init(Mf, 2 * FF, G, bx);
              pg8::EpiSwiGLU E{HID, FF};
              for (int rp_ = 0; rp_ < REP_UP; ++rp_) pg8::gemm_phase<pg8::EpiSwiGLU, pg8::StaticOrder, true, true>(lds3, g, S, E); }
            GRID_SYNC();
            { pg8::Gemm g{HID, (const bf16_t*)(ws + WS_WD) + (size_t)(l * 2 + f) * D * FF, MLAT, D, FF, FF}; pg8::StaticOrder S; S.init(MLAT, D, G, bx);
              pg8::EpiRes E{hlat, hctx, modl, f == 0 ? 2 : 8, 0.5f / REP_DOWN};
              for (int rp_ = 0; rp_ < REP_DOWN; ++rp_) pg8::gemm_phase<pg8::EpiRes, pg8::StaticOrder, true, true>(lds3, g, S, E);
              if (Mf == MTOT) { pg8::Gemm g2{HID, (const bf16_t*)(ws + WS_WD) + (size_t)(l * 2 + f) * D * FF, MTOT, D, 256, FF}; pg8::SplitKOrder S2{8 * 11, G, (bx + 64) % G, 11, 4, 64};
                pg8::EpiResPart E2{PART, modl, f == 0 ? 2 : 8, 0.5f};
                for (int rp_ = 0; rp_ < REP_SK; ++rp_) pg8::gemm_phase<pg8::EpiResPart, pg8::SplitKOrder, false, true>(lds3, g2, S2, E2); } }
            GRID_SYNC();
        }
    }
}

extern "C" void kernel_launch(void* const* d_in, const int* in_sizes, int n_in, void* d_out, int out_size, void* d_ws, size_t ws_size, hipStream_t stream) {
    static int grid = 0;
    if (grid == 0) {
        if (n_in != 31 || ws_size < WS_END) { fprintf(stderr, "kernel_launch: unexpected n_in %d or ws_size %zu < %zu\n", n_in, ws_size, (size_t)WS_END); grid = -1; return; }
        int dev = 0, cus = 0, per_cu = 0;
        (void)hipGetDevice(&dev); (void)hipDeviceGetAttribute(&cus, hipDeviceAttributeMultiprocessorCount, dev);
        if (hipFuncSetAttribute((const void*)mega_fwd, hipFuncAttributeMaxDynamicSharedMemorySize, LDS_BYTES) != hipSuccess) { fprintf(stderr, "kernel_launch: hipFuncSetAttribute failed\n"); grid = -1; return; }
        if (hipOccupancyMaxActiveBlocksPerMultiprocessor(&per_cu, (const void*)mega_fwd, NTHREADS, LDS_BYTES) != hipSuccess || per_cu < 1) { fprintf(stderr, "kernel_launch: occupancy query says %d\n", per_cu); per_cu = 1; }
        (void)hipGetLastError();
        grid = cus;
        fprintf(stderr, "kernel_launch: cus %d per_cu %d grid %d\n", cus, per_cu, grid);
    }
    if (grid < 0) return;
    MegaArgs a{};
    for (int i = 0; i < 31; ++i) a.in[i] = (const float*)d_in[i];
    a.out = (float*)d_out; a.ws = (unsigned char*)d_ws;
    void* args[] = {&a};
    hipError_t e = hipLaunchCooperativeKernel((const void*)mega_fwd, dim3(grid), dim3(NTHREADS), args, LDS_BYTES, stream);
    if (e != hipSuccess) fprintf(stderr, "kernel_launch: cooperative launch failed: %s (grid %d)\n", hipGetErrorString(e), grid);
}
```
